# Optimizing an MI355X kernel written in HIP

```python
import math
import jax, jax.numpy as jnp
from jax import lax
import numpy as np

D_MODEL = 1024
BATCH = 4
SEQ = 8192
DEPTH = 4

CHUNK = 64
QBLOCK = 128
D_FF = 4 * D_MODEL
EPS = 1e-6

A_HEADS = 8
A_KV_HEADS = 2
A_HEAD_DIM = 64
A_WINDOW = 128
A_WINDOW_CHUNKS = A_WINDOW // CHUNK
A_PREV_BLOCKS = -(-(A_WINDOW_CHUNKS * CHUNK) // QBLOCK)
B_HEADS = 8
B_Q_RANK = 256
B_KV_RANK = 128
B_NOPE_DIM = 64
B_ROPE_DIM = 32
B_V_DIM = 64
ROPE_THETA = 10000.0
C_HEADS = 8
C_HEAD_DIM = 64
D_HEADS = 4
D_HEAD_DIM = 64
D_V_DIM = 2 * D_HEAD_DIM

EVEN_SPLITS = [A_HEADS * A_HEAD_DIM, A_KV_HEADS * A_HEAD_DIM, A_KV_HEADS * A_HEAD_DIM,
               B_Q_RANK, B_KV_RANK, B_ROPE_DIM]
EVEN_IN = sum(EVEN_SPLITS)
EVEN_MIX = A_HEADS * A_HEAD_DIM + B_HEADS * B_V_DIM
ODD_SPLITS = [C_HEADS * C_HEAD_DIM] * 3 + [D_HEADS * 2 * D_HEAD_DIM] * 2 + [D_HEADS * D_V_DIM]
ODD_IN = sum(ODD_SPLITS)
ODD_MIX = C_HEADS * C_HEAD_DIM + D_HEADS * D_V_DIM
N_EVEN = (DEPTH + 1) // 2
N_ODD = DEPTH // 2

kernel_name = "hybrid_chunk_causal_encoder"


def rms_norm(x, g):
    xf = x.astype(jnp.float32)
    y = xf * lax.rsqrt(jnp.mean(xf * xf, axis=-1, keepdims=True) + EPS)
    return (y * g.astype(jnp.float32)).astype(x.dtype)


def head_rms(x, g):
    xf = x.astype(jnp.float32)
    return xf * lax.rsqrt(jnp.mean(xf * xf, axis=-1, keepdims=True) + EPS) * g.astype(jnp.float32)


def alibi_slopes(n):
    return 2.0 ** (-8.0 * jnp.arange(1, n + 1, dtype=jnp.float32) / n)


def apply_rope(x, positions):
    half = x.shape[-1] // 2
    inv = ROPE_THETA ** (-jnp.arange(half, dtype=jnp.float32) / half)
    ang = positions.astype(jnp.float32)[:, :, None, None] * inv
    cos, sin = jnp.cos(ang), jnp.sin(ang)
    x1, x2 = x[..., :half], x[..., half:]
    return jnp.concatenate([x1 * cos - x2 * sin, x1 * sin + x2 * cos], axis=-1)


def sweep_query_blocks(block_fn, *q_arrays):
    B, S = q_arrays[0].shape[:2]
    nb = S // QBLOCK
    xs = tuple(jnp.swapaxes(a.reshape((B, nb, QBLOCK) + a.shape[2:]), 0, 1) for a in q_arrays)
    out = lax.map(lambda t: block_fn(t[0], *t[1:]), (jnp.arange(nb),) + xs)
    return jnp.swapaxes(out, 0, 1).reshape((B, S) + out.shape[3:])


def banded_sink_attention(q, k, v, sinks):
    B, S, H, Dh = q.shape
    G = k.shape[2]
    R = H // G
    nb = S // QBLOCK
    qb = q.reshape(B, nb, QBLOCK, G, R, Dh)

    def band(t):
        tb = t.reshape(B, nb, QBLOCK, G, Dh)
        prev = [jnp.pad(tb, ((0, 0), (p, 0), (0, 0), (0, 0), (0, 0)))[:, :nb]
                for p in range(A_PREV_BLOCKS, 0, -1)]
        return jnp.concatenate(prev + [tb], axis=2)

    kk, vv = band(k), band(v)
    nk = kk.shape[2]
    blk = jnp.arange(nb)[:, None]
    qpos = blk * QBLOCK + jnp.arange(QBLOCK)[None]
    kpos = (blk - A_PREV_BLOCKS) * QBLOCK + jnp.arange(nk)[None]
    dchunk = qpos[:, :, None] // CHUNK - kpos[:, None, :] // CHUNK
    allowed = (kpos[:, None, :] >= 0) & (dchunk >= 0) & (dchunk <= A_WINDOW_CHUNKS)
    dist = jnp.abs(qpos[:, :, None] - kpos[:, None, :]).astype(jnp.float32)
    slopes = alibi_slopes(H).reshape(G, R)
    s = jnp.einsum('bnqgrd,bnkgd->bngrqk', qb, kk) * (Dh ** -0.5)
    s = s - slopes[None, None, :, :, None, None] * dist[None, :, None, None]
    s = jnp.where(allowed[None, :, None, None], s, -jnp.inf)
    sink = sinks.astype(jnp.float32).reshape(1, 1, G, R, 1, 1)
    m = jnp.maximum(jnp.max(s, axis=-1, keepdims=True), sink)
    p = jnp.exp(s - m)
    w = p / (jnp.sum(p, axis=-1, keepdims=True) + jnp.exp(sink - m))
    o = jnp.einsum('bngrqk,bnkgd->bnqgrd', w, vv)
    return o.reshape(B, S, H, Dh)


def chunk_causal_softmax_attention(q, k, v):
    S = q.shape[1]
    scale = q.shape[-1] ** -0.5
    kchunk = jnp.arange(S) // CHUNK

    def block(i, qb):
        qchunk = (i * QBLOCK + jnp.arange(QBLOCK)) // CHUNK
        allowed = kchunk[None, :] <= qchunk[:, None]
        s = jnp.einsum('bqhd,bkhd->bhqk', qb, k) * scale
        p = jax.nn.softmax(jnp.where(allowed, s, -jnp.inf), axis=-1)
        return jnp.einsum('bhqk,bkhd->bqhd', p, v)

    return sweep_query_blocks(block, q)


def stick_breaking_attention(q, k, v):
    S, Dh = q.shape[1], q.shape[-1]
    kpos = jnp.arange(S)

    def block(i, qb):
        qpos = i * QBLOCK + jnp.arange(QBLOCK)
        strict = kpos[None, :] < qpos[:, None]
        z = jnp.einsum('bqhd,bkhd->bhqk', qb, k) * (Dh ** -0.5)
        log1m = jnp.where(strict, -jax.nn.softplus(z), 0.0)
        between = lax.cumsum(log1m, axis=3, reverse=True) - log1m
        a = jnp.where(strict, jnp.exp(jax.nn.log_sigmoid(z) + between), 0.0)
        return jnp.einsum('bhqk,bkhd->bqhd', a, v)

    return sweep_query_blocks(block, q)


def differential_attention(q1, q2, k1, k2, v, lam):
    S, H, Dh = q1.shape[1], q1.shape[2], q1.shape[-1]
    scale = Dh ** -0.5
    kpos = jnp.arange(S)
    slopes = alibi_slopes(H)

    def block(i, q1b, q2b):
        qpos = i * QBLOCK + jnp.arange(QBLOCK)
        allowed = (kpos[None, :] // CHUNK) <= (qpos[:, None] // CHUNK)
        dist = jnp.abs(qpos[:, None] - kpos[None, :]).astype(jnp.float32)
        bias = -slopes[:, None, None] * dist[None]
        s1 = jnp.einsum('bqhd,bkhd->bhqk', q1b, k1) * scale + bias
        s2 = jnp.einsum('bqhd,bkhd->bhqk', q2b, k2) * scale + bias
        p1 = jax.nn.softmax(jnp.where(allowed, s1, -jnp.inf), axis=-1)
        p2 = jax.nn.softmax(jnp.where(allowed, s2, -jnp.inf), axis=-1)
        return jnp.einsum('bhqk,bkhd->bqhd', p1 - lam * p2, v)

    return sweep_query_blocks(block, q1, q2)


def even_mixer(h, positions, w_in, w_out, a_qg, a_kg, a_sinks, b_cqg, b_ckvg, b_w_uq, b_w_ukv, b_qg, b_kg):
    B, S, _ = h.shape
    proj = h @ w_in
    aq, ak, av, cq, ckv, krope = jnp.split(proj, np.cumsum(EVEN_SPLITS)[:-1].tolist(), axis=-1)
    qa = head_rms(aq.reshape(B, S, A_HEADS, A_HEAD_DIM), a_qg)
    ka = head_rms(ak.reshape(B, S, A_KV_HEADS, A_HEAD_DIM), a_kg)
    va = av.reshape(B, S, A_KV_HEADS, A_HEAD_DIM).astype(jnp.float32)
    oa = banded_sink_attention(qa, ka, va, a_sinks)
    cq = rms_norm(cq, b_cqg)
    ckv = rms_norm(ckv, b_ckvg)
    qb = (cq @ b_w_uq).reshape(B, S, B_HEADS, B_NOPE_DIM + B_ROPE_DIM)
    kv = (ckv @ b_w_ukv).reshape(B, S, B_HEADS, B_NOPE_DIM + B_V_DIM)
    kb = jnp.concatenate([kv[..., :B_NOPE_DIM],
                          jnp.broadcast_to(krope[:, :, None, :], (B, S, B_HEADS, B_ROPE_DIM))], axis=-1)
    vb = kv[..., B_NOPE_DIM:].astype(jnp.float32)
    qb = head_rms(qb, b_qg)
    kb = head_rms(kb, b_kg)
    qb = jnp.concatenate([qb[..., :B_NOPE_DIM], apply_rope(qb[..., B_NOPE_DIM:], positions)], axis=-1)
    kb = jnp.concatenate([kb[..., :B_NOPE_DIM], apply_rope(kb[..., B_NOPE_DIM:], positions)], axis=-1)
    ob = chunk_causal_softmax_attention(qb, kb, vb)
    mix = jnp.concatenate([oa.reshape(B, S, -1), ob.reshape(B, S, -1)], axis=-1).astype(h.dtype)
    return mix @ w_out


def odd_mixer(h, w_in, w_out, d_qg, d_kg, d_lam, d_subln, lambda_init):
    B, S, _ = h.shape
    proj = h @ w_in
    cq, ck, cv, dq, dk, dv = jnp.split(proj, np.cumsum(ODD_SPLITS)[:-1].tolist(), axis=-1)
    f32 = jnp.float32
    oc = stick_breaking_attention(cq.reshape(B, S, C_HEADS, C_HEAD_DIM).astype(f32),
                                  ck.reshape(B, S, C_HEADS, C_HEAD_DIM).astype(f32),
                                  cv.reshape(B, S, C_HEADS, C_HEAD_DIM).astype(f32))
    q = head_rms(dq.reshape(B, S, D_HEADS, 2, D_HEAD_DIM), d_qg)
    k = head_rms(dk.reshape(B, S, D_HEADS, 2, D_HEAD_DIM), d_kg)
    v = dv.reshape(B, S, D_HEADS, D_V_DIM).astype(f32)
    lf = d_lam.astype(f32)
    lam = jnp.exp(jnp.sum(lf[0] * lf[1])) - jnp.exp(jnp.sum(lf[2] * lf[3])) + lambda_init
    od = differential_attention(q[:, :, :, 0], q[:, :, :, 1], k[:, :, :, 0], k[:, :, :, 1], v, lam)
    od = head_rms(od, d_subln) * (1.0 - lambda_init)
    mix = jnp.concatenate([oc.reshape(B, S, -1), od.reshape(B, S, -1)], axis=-1).astype(h.dtype)
    return mix @ w_out


def squared_relu_mlp(h, w_up, w_down):
    return jnp.square(jax.nn.relu(h @ w_up)) @ w_down


def setup_inputs(seed: int = 0) -> dict:
    key = jax.random.key(seed)
    ks = jax.random.split(key, 23)
    f32 = jnp.float32

    def nrm(i, shape, scale):
        return jax.random.normal(ks[i], shape, f32) * scale

    def gain(i, shape):
        return 1.0 + 0.1 * jax.random.normal(ks[i], shape, f32)

    x = jax.random.normal(ks[0], (BATCH, SEQ, D_MODEL), f32)
    offset = jax.random.randint(ks[1], (BATCH, 1), 0, 4096, dtype=jnp.int32)
    positions = jnp.arange(SEQ, dtype=jnp.int32)[None, :] + offset
    return {
        "x": x,
        "positions": positions,
        "norm_mix_g": gain(2, (DEPTH, D_MODEL)),
        "norm_ffn_g": gain(3, (DEPTH, D_MODEL)),
        "mlp_w_up": nrm(4, (DEPTH, D_MODEL, D_FF), D_MODEL ** -0.5),
        "mlp_w_down": nrm(5, (DEPTH, D_FF, D_MODEL), D_FF ** -0.5),
        "ev_w_in": nrm(6, (N_EVEN, D_MODEL, EVEN_IN), D_MODEL ** -0.5),
        "ev_w_out": nrm(7, (N_EVEN, EVEN_MIX, D_MODEL), EVEN_MIX ** -0.5),
        "a_q_norm": gain(8, (N_EVEN, A_HEAD_DIM)),
        "a_k_norm": gain(9, (N_EVEN, A_HEAD_DIM)),
        "a_sinks": nrm(10, (N_EVEN, A_HEADS), 0.5),
        "b_cq_norm": gain(11, (N_EVEN, B_Q_RANK)),
        "b_ckv_norm": gain(12, (N_EVEN, B_KV_RANK)),
        "b_w_uq": nrm(13, (N_EVEN, B_Q_RANK, B_HEADS * (B_NOPE_DIM + B_ROPE_DIM)), B_Q_RANK ** -0.5),
        "b_w_ukv": nrm(14, (N_EVEN, B_KV_RANK, B_HEADS * (B_NOPE_DIM + B_V_DIM)), B_KV_RANK ** -0.5),
        "b_q_norm": gain(15, (N_EVEN, B_NOPE_DIM + B_ROPE_DIM)),
        "b_k_norm": gain(16, (N_EVEN, B_NOPE_DIM + B_ROPE_DIM)),
        "od_w_in": nrm(17, (N_ODD, D_MODEL, ODD_IN), D_MODEL ** -0.5),
        "od_w_out": nrm(18, (N_ODD, ODD_MIX, D_MODEL), ODD_MIX ** -0.5),
        "d_q_norm": gain(19, (N_ODD, 2, D_HEAD_DIM)),
        "d_k_norm": gain(20, (N_ODD, 2, D_HEAD_DIM)),
        "d_lambda": nrm(21, (N_ODD, 4, D_HEAD_DIM), 0.1),
        "d_subln": gain(22, (N_ODD, D_V_DIM)),
    }


def reference(x, positions, norm_mix_g, norm_ffn_g, mlp_w_up, mlp_w_down, ev_w_in, ev_w_out,
              a_q_norm, a_k_norm, a_sinks, b_cq_norm, b_ckv_norm, b_w_uq, b_w_ukv, b_q_norm, b_k_norm,
              od_w_in, od_w_out, d_q_norm, d_k_norm, d_lambda, d_subln):
    for layer in range(DEPTH):
        j = layer // 2
        h = rms_norm(x, norm_mix_g[layer])
        if layer % 2 == 0:
            mix = even_mixer(h, positions, ev_w_in[j], ev_w_out[j], a_q_norm[j], a_k_norm[j], a_sinks[j],
                             b_cq_norm[j], b_ckv_norm[j], b_w_uq[j], b_w_ukv[j], b_q_norm[j], b_k_norm[j])
        else:
            lambda_init = 0.8 - 0.6 * math.exp(-0.3 * layer)
            mix = odd_mixer(h, od_w_in[j], od_w_out[j], d_q_norm[j], d_k_norm[j], d_lambda[j], d_subln[j],
                            lambda_init)
        x = x + mix
        h = rms_norm(x, norm_ffn_g[layer])
        x = x + squared_relu_mlp(h, mlp_w_up[layer], mlp_w_down[layer])
    return x
```

```cpp
#include <hip/hip_runtime.h>
#include <hip/hip_cooperative_groups.h>
#include <cstdio>
#include <cstdint>
namespace cg = cooperative_groups;

#ifndef PROBE_KIND
#define PROBE_KIND -1
#endif
#ifndef MULTI_LAUNCH
#define MULTI_LAUNCH 0
#endif

typedef unsigned short bf16_t;
typedef short bf16x8 __attribute__((ext_vector_type(8)));
typedef short s16x4 __attribute__((ext_vector_type(4)));
typedef float f32x16 __attribute__((ext_vector_type(16)));
typedef float f32x4 __attribute__((ext_vector_type(4)));
typedef float f32x2 __attribute__((ext_vector_type(2)));
typedef __bf16 bf16x2_t __attribute__((ext_vector_type(2)));
typedef unsigned u32x2 __attribute__((ext_vector_type(2)));
typedef unsigned u32x4 __attribute__((ext_vector_type(4)));
#define DI __device__ __forceinline__
#define LDS_AS __attribute__((address_space(3)))

constexpr int T = 32768, S = 8192, DM = 1024, DFF = 4096;
constexpr float EPS = 1e-6f;
constexpr float LOG2E = 1.4426950408889634f;
constexpr int NPHASE = 23;
constexpr int NT = 512;
constexpr int LDS_TILE_BYTES = 147456;
constexpr int LDS_BYTES = LDS_TILE_BYTES + 128;

constexpr size_t MiB = 1024 * 1024;
constexpr size_t WS_XB = 0;
constexpr size_t WS_MIX = 64 * MiB;
constexpr size_t WS_HID = 128 * MiB;
constexpr size_t WS_W = 384 * MiB;
constexpr size_t W_IN_E = 0;
constexpr size_t W_UQ = W_IN_E + 2ull * 1280 * 1024 * 2;
constexpr size_t W_UKV = W_UQ + 2ull * 1024 * 256 * 2;
constexpr size_t W_OUT_E = W_UKV + 2ull * 1024 * 128 * 2;
constexpr size_t W_IN_O = W_OUT_E + 2ull * 1024 * 1024 * 2;
constexpr size_t W_OUT_O = W_IN_O + 2ull * 3072 * 1024 * 2;
constexpr size_t W_UP = W_OUT_O + 2ull * 1024 * 1024 * 2;
constexpr size_t W_DN = W_UP + 4ull * 4096 * 1024 * 2;
constexpr size_t W_END = W_DN + 4ull * 4096 * 1024 * 2;
constexpr size_t WS_CTR = WS_W + W_END;
constexpr size_t WS_BAR = WS_CTR + 256;
constexpr size_t WS_STASH = WS_BAR + 16384;
constexpr size_t WS_END = WS_STASH + 256ull * 131072;
constexpr size_t TE = (size_t)T;
constexpr size_t E_QA = 0, E_KA = E_QA + TE * 512, E_VA = E_KA + TE * 128, E_CQ = E_VA + TE * 128, E_CKV = E_CQ + TE * 256,
                 E_QB = E_CKV + TE * 128, E_KB = E_QB + TE * 768, E_VB = E_KB + TE * 768, E_KR = E_VB + TE * 512  ;
constexpr size_t O_QC = 0, O_KC = TE * 512, O_VC = TE * 1024, O_QD = TE * 1536, O_KD = TE * 2048, O_VD = TE * 2560;

struct Params {
  const float* in[23];
  float* out;
  unsigned char* ws;
};

DI unsigned pack2(float lo, float hi) {
  f32x2 f = {lo, hi};
  bf16x2_t b = __builtin_convertvector(f, bf16x2_t);
  return __builtin_bit_cast(unsigned, b);
}
DI void st4(bf16_t* p, float a, float b, float c, float d) {
  u32x2 v = {pack2(a, b), pack2(c, d)};
  *(u32x2*)p = v;
}
DI bf16x8 pack8(const f32x16& x, int o) {
  u32x4 v = {pack2(x[o], x[o + 1]), pack2(x[o + 2], x[o + 3]), pack2(x[o + 4], x[o + 5]), pack2(x[o + 6], x[o + 7])};
  return __builtin_bit_cast(bf16x8, v);
}
DI float ex2(float x) { return __builtin_amdgcn_exp2f(x); }
DI float lg2(float x) { return __builtin_amdgcn_logf(x); }
DI float xor32(float x) { return __shfl_xor(x, 32); }
#define MFMA(a, b, c) __builtin_amdgcn_mfma_f32_32x32x16_bf16((a), (b), (c), 0, 0, 0)
DI int opaque_tid() { int t = threadIdx.x; asm volatile("" : "+v"(t)); return t; }
DI f32x16 zero16() { f32x16 z; for (int i = 0; i < 16; ++i) z[i] = 0.f; return z; }

DI void tconv(const float* __restrict__ src, const float* __restrict__ gain, int N, int K, bf16_t* __restrict__ dst, int Npad, int grp,
              int grp_pad, unsigned char* lds) {
  const int tid5 = opaque_tid();
  const int half = tid5 >> 8, tid = tid5 & 255;
  float* tile = (float*)lds + half * (64 * 33);
  const int nkt = K >> 6, ntl = (Npad >> 5) * nkt;
  for (int tt = blockIdx.x; 2 * tt < ntl; tt += gridDim.x) {
    const int t = 2 * tt + half;
    const bool active = t < ntl;
    const int ntile = t / nkt, kt = t - ntile * nkt;
    const int np0 = ntile * 32, k0 = kt * 64;
    const int gi = np0 / grp_pad, go = np0 - gi * grp_pad;
    const int sn0 = gi * grp + go;
    const bool valid = active && (go < grp) && (sn0 < N);
    if (valid) {
#pragma unroll
      for (int p = 0; p < 2; ++p) {
        const int kk = (tid >> 3) + 32 * p, nn = (tid & 7) * 4;
        const f32x4 v = *(const f32x4*)(src + (size_t)(k0 + kk) * N + sn0 + nn);
        const float gsc = gain ? gain[k0 + kk] : 1.f;
#pragma unroll
        for (int e = 0; e < 4; ++e) tile[kk * 33 + nn + e] = v[e] * gsc;
      }
    }
    __syncthreads();
    if (active) {
      const int n = tid >> 3, kq = (tid & 7) * 8;
      u32x4 o = {0u, 0u, 0u, 0u};
      if (valid) {
        float f[8];
#pragma unroll
        for (int j = 0; j < 8; ++j) f[j] = tile[(kq + j) * 33 + n];
        o[0] = pack2(f[0], f[1]); o[1] = pack2(f[2], f[3]); o[2] = pack2(f[4], f[5]); o[3] = pack2(f[6], f[7]);
      }
      *(u32x4*)(dst + (size_t)(np0 + n) * K + k0 + kq) = o;
    }
    __syncthreads();
  }
}

DI void prologue(const Params& p, unsigned char* lds) {
  unsigned char* wb = p.ws + WS_W;
  if (blockIdx.x == 0 && threadIdx.x < 16) ((int*)(p.ws + WS_CTR))[threadIdx.x] = 0;
  {
    const float* x = p.in[0];
    bf16_t* xb = (bf16_t*)(p.ws + WS_XB);
    const size_t n8 = (size_t)T * DM / 8;
    for (size_t i = (size_t)blockIdx.x * NT + threadIdx.x; i < n8; i += (size_t)gridDim.x * NT) {
      const f32x4 a = *(const f32x4*)(x + i * 8), b = *(const f32x4*)(x + i * 8 + 4);
      u32x4 o = {pack2(a[0], a[1]), pack2(a[2], a[3]), pack2(b[0], b[1]), pack2(b[2], b[3])};
      *(u32x4*)(xb + i * 8) = o;
    }
  }
  for (int j = 0; j < 2; ++j) {
    tconv(p.in[6] + (size_t)j * 1024 * 1184, p.in[2] + (2 * j) * 1024, 1184, 1024, (bf16_t*)(wb + W_IN_E) + (size_t)j * 1280 * 1024, 1280, 1280, 1280, lds);
    tconv(p.in[13] + (size_t)j * 256 * 768, p.in[11] + j * 256, 768, 256, (bf16_t*)(wb + W_UQ) + (size_t)j * 1024 * 256, 1024, 96, 128, lds);
    tconv(p.in[14] + (size_t)j * 128 * 1024, nullptr, 1024, 128, (bf16_t*)(wb + W_UKV) + (size_t)j * 1024 * 128, 1024, 1024, 1024, lds);
    tconv(p.in[7] + (size_t)j * 1024 * 1024, nullptr, 1024, 1024, (bf16_t*)(wb + W_OUT_E) + (size_t)j * 1024 * 1024, 1024, 1024, 1024, lds);
    tconv(p.in[17] + (size_t)j * 1024 * 3072, p.in[2] + (2 * j + 1) * 1024, 3072, 1024, (bf16_t*)(wb + W_IN_O) + (size_t)j * 3072 * 1024, 3072, 3072, 3072, lds);
    tconv(p.in[18] + (size_t)j * 1024 * 1024, nullptr, 1024, 1024, (bf16_t*)(wb + W_OUT_O) + (size_t)j * 1024 * 1024, 1024, 1024, 1024, lds);
  }
  for (int L = 0; L < 4; ++L) {
    tconv(p.in[4] + (size_t)L * 1024 * 4096, p.in[3] + L * 1024, 4096, 1024, (bf16_t*)(wb + W_UP) + (size_t)L * 4096 * 1024, 4096, 4096, 4096, lds);
    tconv(p.in[5] + (size_t)L * 4096 * 1024, nullptr, 1024, 4096, (bf16_t*)(wb + W_DN) + (size_t)L * 1024 * 4096, 1024, 1024, 1024, lds);
  }
}

constexpr int G_OP = 256 * 64;
constexpr int G_STAGE = 2 * G_OP;
constexpr int G_NST = 4;
static_assert(G_NST * G_STAGE <= LDS_TILE_BYTES, "LDS ring");

DI void tile_map(int t, int Ntiles, int& mt, int& nt) {
  const int xcd = t & 7, j = t >> 3;
  const int per = 4 * Ntiles;
  const int g = j / per, r = j - g * per;
  nt = r >> 2;
  mt = (g * 4 + (r & 3)) * 8 + xcd;
}

template <bool ROWSS>
DI void frag_ss(const bf16x8& af, float& ss) {
  if (ROWSS) {
    typedef __bf16 bf2 __attribute__((ext_vector_type(2)));
    typedef __bf16 bf8 __attribute__((ext_vector_type(8)));
    const bf8 v = __builtin_bit_cast(bf8, af);
#pragma unroll
    for (int e = 0; e < 4; ++e) {
      const bf2 t = {v[2 * e], v[2 * e + 1]};
      ss = __builtin_amdgcn_fdot2_f32_bf16(t, t, ss, false);
    }
  }
}

DI void lds_barrier() {
  __builtin_amdgcn_s_waitcnt(0xC07F);
  __builtin_amdgcn_s_barrier();
  asm volatile("" ::: "memory");
}

template <bool ROWSS, class Epi>
DI void gemm_phase(const bf16_t* A, int lda, const bf16_t* Bt, int K, int Ntiles, const Epi& epi, unsigned char* lds) {
  const int tid = opaque_tid(), lane = tid & 63, w = tid >> 6, h = lane >> 5, r = lane & 31;
  const int wm = w & 3, wn = w >> 2;
  const int ntiles = (T / 256) * Ntiles;
  const int nk = K >> 5;
  const int fsw = (h ^ ((r >> 2) & 3)) * 16;
  const int a_off = (64 * wm + r) * 64 + fsw;
  const int b_off = G_OP + (128 * wn + r) * 64 + fsw;
  const int grow = lane >> 2, gch = ((lane & 3) ^ ((lane >> 4) & 3)) * 8;
  const int wu = __builtin_amdgcn_readfirstlane(w);
  int t = blockIdx.x;
  int m0 = 0, nt = 0;
  const bf16_t* ag = A;
  const bf16_t* bg = Bt;
  auto set_tile = [&](int tt) {
    int mt_;
    tile_map(tt, Ntiles, mt_, nt);
    m0 = mt_ * 256;
    ag = A + (size_t)(m0 + 16 * w + grow) * lda + gch;
    bg = Bt + (size_t)(nt * 256 + 16 * w + grow) * K + gch;
  };
  bool primed = false;
  while (t < ntiles) {
    auto glds1 = [&](int kt, int piece) {
      unsigned char* st = lds + (kt & (G_NST - 1)) * G_STAGE + wu * 1024;
      const int k0 = kt * 32;
      if (piece == 0) __builtin_amdgcn_global_load_lds((const unsigned*)(ag + k0), (unsigned*)(st), 16, 0, 0);
      if (piece == 1) __builtin_amdgcn_global_load_lds((const unsigned*)(ag + (size_t)128 * lda + k0), (unsigned*)(st + 8192), 16, 0, 0);
      if (piece == 2) __builtin_amdgcn_global_load_lds((const unsigned*)(bg + k0), (unsigned*)(st + G_OP), 16, 0, 0);
      if (piece == 3) __builtin_amdgcn_global_load_lds((const unsigned*)(bg + (size_t)128 * K + k0), (unsigned*)(st + G_OP + 8192), 16, 0, 0);
    };
    auto glds = [&](int kt) { glds1(kt, 0); glds1(kt, 1); glds1(kt, 2); glds1(kt, 3); };
    if (!primed) {
      set_tile(t);
      asm volatile("s_waitcnt vmcnt(0)" ::: "memory");
      glds(0); glds(1); glds(2);
      primed = true;
    }
    f32x16 acc[2][4];
#pragma unroll
    for (int mb = 0; mb < 2; ++mb)
#pragma unroll
      for (int nb = 0; nb < 4; ++nb) acc[mb][nb] = zero16();
    float ss0 = 0.f, ss1 = 0.f;
    bf16x8 af0[2], wf0[4], af1[2], wf1[4];
    for (int kt = 0; kt < nk; ++kt) {
      if (kt + 2 < nk) asm volatile("s_waitcnt vmcnt(4)" ::: "memory"); else asm volatile("s_waitcnt vmcnt(0)" ::: "memory");
      lds_barrier();
      const bool pf = kt + 3 < nk;
      const unsigned char* sc = lds + (kt & (G_NST - 1)) * G_STAGE;
      if (kt == 0) {
#pragma unroll
        for (int mb = 0; mb < 2; ++mb) af0[mb] = *(const bf16x8*)(sc + a_off + 2048 * mb);
#pragma unroll
        for (int nb = 0; nb < 4; ++nb) wf0[nb] = *(const bf16x8*)(sc + b_off + 2048 * nb);
      }
#pragma unroll
      for (int mb = 0; mb < 2; ++mb) af1[mb] = *(const bf16x8*)(sc + (a_off ^ 32) + 2048 * mb);
#pragma unroll
      for (int nb = 0; nb < 4; ++nb) wf1[nb] = *(const bf16x8*)(sc + (b_off ^ 32) + 2048 * nb);
      __builtin_amdgcn_sched_barrier(0);
      frag_ss<ROWSS>(af0[0], ss0);
      frag_ss<ROWSS>(af0[1], ss1);
#pragma unroll
      for (int nb = 0; nb < 4; ++nb) {
#pragma unroll
        for (int mb = 0; mb < 2; ++mb) acc[mb][nb] = MFMA(wf0[nb], af0[mb], acc[mb][nb]);
        if (nb == 1) { __builtin_amdgcn_sched_barrier(0); if (pf) glds1(kt + 3, 0); __builtin_amdgcn_sched_barrier(0); }
        if (nb == 3) { __builtin_amdgcn_sched_barrier(0); if (pf) glds1(kt + 3, 1); }
      }
      __builtin_amdgcn_sched_barrier(0);
      __builtin_amdgcn_sched_barrier(0);
      frag_ss<ROWSS>(af1[0], ss0);
      frag_ss<ROWSS>(af1[1], ss1);
#pragma unroll
      for (int nb = 0; nb < 4; ++nb) {
#pragma unroll
        for (int mb = 0; mb < 2; ++mb) acc[mb][nb] = MFMA(wf1[nb], af1[mb], acc[mb][nb]);
        if (nb == 0) {
          __builtin_amdgcn_sched_barrier(0);
          if (kt + 1 < nk) {
            const unsigned char* sn = lds + ((kt + 1) & (G_NST - 1)) * G_STAGE;
#pragma unroll
            for (int mb = 0; mb < 2; ++mb) af0[mb] = *(const bf16x8*)(sn + a_off + 2048 * mb);
#pragma unroll
            for (int nb2 = 0; nb2 < 4; ++nb2) wf0[nb2] = *(const bf16x8*)(sn + b_off + 2048 * nb2);
          }
          __builtin_amdgcn_sched_barrier(0);
        }
        if (nb == 1) { __builtin_amdgcn_sched_barrier(0); if (pf) glds1(kt + 3, 2); __builtin_amdgcn_sched_barrier(0); }
        if (nb == 3) { __builtin_amdgcn_sched_barrier(0); if (pf) glds1(kt + 3, 3); }
      }
      __builtin_amdgcn_sched_barrier(0);
    }
    lds_barrier();
    float rs0 = 1.f, rs1 = 1.f;
    if (ROWSS) {
      ss0 += xor32(ss0);
      ss1 += xor32(ss1);
      rs0 = rsqrtf(ss0 / (float)K + EPS);
      rs1 = rsqrtf(ss1 / (float)K + EPS);
    }
    const int mrow = m0 + 64 * wm + r, nt128 = 2 * nt + wn;
    t += gridDim.x;
    if (t < ntiles) { set_tile(t); glds(0); glds(1); glds(2); }
    epi(acc[0], mrow, nt128, h, rs0);
    epi(acc[1], mrow + 32, nt128, h, rs1);
  }
}

DI void swap8(const f32x16& a, int p, float (&v)[8]) {
#pragma unroll
  for (int e = 0; e < 4; ++e) {
    const auto r = __builtin_amdgcn_permlane32_swap(__float_as_uint(a[8 * p + e]), __float_as_uint(a[8 * p + 4 + e]), false, false);
    v[e] = __uint_as_float(r[0]);
    v[4 + e] = __uint_as_float(r[1]);
  }
}
DI u32x4 pk8(const float (&v)[8], float r, const float* gain) {
  float o[8];
  if (gain) {
    const f32x4 g0 = *(const f32x4*)(gain), g1 = *(const f32x4*)(gain + 4);
#pragma unroll
    for (int e = 0; e < 4; ++e) { o[e] = v[e] * r * g0[e]; o[4 + e] = v[4 + e] * r * g1[e]; }
  } else {
#pragma unroll
    for (int e = 0; e < 8; ++e) o[e] = v[e] * r;
  }
  return (u32x4){pack2(o[0], o[1]), pack2(o[2], o[3]), pack2(o[4], o[5]), pack2(o[6], o[7])};
}
DI void st8(bf16_t* p, const float (&v)[8], float r, const float* gain) {
  float o[8];
  if (gain) {
    const f32x4 g0 = *(const f32x4*)(gain), g1 = *(const f32x4*)(gain + 4);
#pragma unroll
    for (int e = 0; e < 4; ++e) { o[e] = v[e] * r * g0[e]; o[4 + e] = v[4 + e] * r * g1[e]; }
  } else {
#pragma unroll
    for (int e = 0; e < 8; ++e) o[e] = v[e] * r;
  }
  u32x4 u = {pack2(o[0], o[1]), pack2(o[2], o[3]), pack2(o[4], o[5]), pack2(o[6], o[7])};
  *(u32x4*)p = u;
}
constexpr int EPI_LDS = 3 * G_STAGE;
DI void stage_put(unsigned char* reg, int r, int chunk, const u32x4& o) { *(u32x4*)(reg + r * 128 + ((chunk ^ (r & 7)) << 4)) = o; }
DI void stage_flush(unsigned char* reg, bf16_t* dst0, size_t ld) {
  const int lane = opaque_tid() & 63;
  __builtin_amdgcn_s_waitcnt(0xC07F);
#pragma unroll
  for (int q = 0; q < 4; ++q) {
    const int row = 8 * q + (lane >> 3), phys = lane & 7;
    const u32x4 v = *(const u32x4*)(reg + row * 128 + (phys << 4));
    *(u32x4*)(dst0 + (size_t)row * ld + ((phys ^ (row & 7)) << 3)) = v;
  }
  __builtin_amdgcn_s_waitcnt(0xC07F);
  __builtin_amdgcn_sched_barrier(0);
}
struct EpiResid {
  const float* res_f32; bf16_t* xb; float* out_f32; unsigned char* lds;
  DI void operator()(f32x16 (&acc)[4], int m, int nt, int h, float) const {
    const size_t base = (size_t)m * DM + nt * 128;
    const int r = m & 31;
    unsigned char* reg = lds + EPI_LDS + (opaque_tid() >> 6) * 4096;
#pragma unroll
    for (int nb = 0; nb < 4; ++nb) {
#pragma unroll
      for (int p = 0; p < 2; ++p) {
        const int c = 32 * nb + 8 * (2 * p + h);
        float v[8];
        swap8(acc[nb], p, v);
        if (res_f32) {
          const f32x4 r0 = *(const f32x4*)(res_f32 + base + c), r1 = *(const f32x4*)(res_f32 + base + c + 4);
#pragma unroll
          for (int e = 0; e < 4; ++e) { v[e] += r0[e]; v[4 + e] += r1[e]; }
        } else {
          const u32x4 u = *(const u32x4*)(xb + base + c);
#pragma unroll
          for (int e = 0; e < 4; ++e) { v[2 * e] += __uint_as_float(u[e] << 16); v[2 * e + 1] += __uint_as_float(u[e] & 0xffff0000u); }
        }
        if (out_f32) {
          *(f32x4*)(out_f32 + base + c) = (f32x4){v[0], v[1], v[2], v[3]};
          *(f32x4*)(out_f32 + base + c + 4) = (f32x4){v[4], v[5], v[6], v[7]};
        } else {
          const u32x4 o = {pack2(v[0], v[1]), pack2(v[2], v[3]), pack2(v[4], v[5]), pack2(v[6], v[7])};
          stage_put(reg, r, 4 * (nb & 1) + 2 * p + h, o);
        }
      }
      if (!out_f32 && (nb & 1)) stage_flush(reg, xb + (size_t)(m - r) * DM + nt * 128 + 64 * (nb >> 1), DM);
    }
  }
};
struct EpiRelu2 {
  bf16_t* hid; unsigned char* lds;
  DI void operator()(f32x16 (&acc)[4], int m, int nt, int h, float rs) const {
    const int r = m & 31;
    unsigned char* reg = lds + EPI_LDS + (opaque_tid() >> 6) * 4096;
    bf16_t* blk = hid + (size_t)(m - r) * DFF + nt * 128;
#pragma unroll
    for (int ch = 0; ch < 2; ++ch) {
#pragma unroll
      for (int nb2 = 0; nb2 < 2; ++nb2)
#pragma unroll
        for (int p = 0; p < 2; ++p) {
          float v[8];
          swap8(acc[2 * ch + nb2], p, v);
#pragma unroll
          for (int e = 0; e < 8; ++e) { const float a = fmaxf(v[e] * rs, 0.f); v[e] = a * a; }
          const u32x4 o = {pack2(v[0], v[1]), pack2(v[2], v[3]), pack2(v[4], v[5]), pack2(v[6], v[7])};
          stage_put(reg, r, 4 * nb2 + 2 * p + h, o);
        }
      stage_flush(reg, blk + 64 * ch, DFF);
    }
  }
};
constexpr float QS_64 = 0.125f * LOG2E;
constexpr float QS_96 = 0.10206207261596575f * LOG2E;

struct EpiEvenIn {
  bf16_t* hb; const float *a_qg, *a_kg, *b_ckvg; unsigned char* lds;
  DI void operator()(f32x16 (&acc)[4], int m, int nt, int h, float rs) const {
    const int b = m >> 13, s = m & (S - 1);
    unsigned char* sreg = lds + EPI_LDS + (opaque_tid() >> 6) * 4096;
    if (nt < 6) {
#pragma unroll
      for (int hh = 0; hh < 2; ++hh) {
        float r = rs;
        const float* gain = nullptr;
        bf16_t* dst;
        if (nt < 5) {
          float ss = 0.f;
#pragma unroll
          for (int x = 0; x < 2; ++x)
#pragma unroll
            for (int i = 0; i < 16; ++i) { const float v = acc[2 * hh + x][i] * rs; ss = fmaf(v, v, ss); }
          ss += xor32(ss);
          r = rsqrtf(ss * (1.f / 64.f) + EPS) * rs;
          if (nt < 4) { gain = a_qg; r *= QS_64; } else gain = a_kg;
        }
        {
          const size_t off = (nt < 4) ? E_QA + ((size_t)(b * 8 + 2 * nt + hh) * S + s) * 64
                                      : E_KA + (size_t)(nt - 4) * (TE * 128) + ((size_t)(b * 2 + hh) * S + s) * 64;
          dst = hb + off;
        }
#pragma unroll
        for (int x = 0; x < 2; ++x)
#pragma unroll
          for (int pq = 0; pq < 2; ++pq) {
            const int d = 32 * x + 8 * (2 * pq + h);
            float v[8];
            swap8(acc[2 * hh + x], pq, v);
            stage_put(sreg, m & 31, 4 * x + 2 * pq + h, pk8(v, r, gain ? gain + d : nullptr));
          }
        stage_flush(sreg, dst - (m & 31) * 64, 64);
      }
    } else if (nt < 8) {
      bf16_t* dst = hb + E_CQ + (size_t)m * 256 + (nt - 6) * 128;
#pragma unroll
      for (int nb = 0; nb < 4; ++nb) {
#pragma unroll
        for (int pq = 0; pq < 2; ++pq) {
          float v[8];
          swap8(acc[nb], pq, v);
          stage_put(sreg, m & 31, 4 * (nb & 1) + 2 * pq + h, pk8(v, rs, nullptr));
        }
        if (nb & 1) stage_flush(sreg, dst - (size_t)(m & 31) * 256 + 64 * (nb >> 1), 256);
      }
    } else if (nt == 8) {
      float ss = 0.f;
#pragma unroll
      for (int nb = 0; nb < 4; ++nb)
#pragma unroll
        for (int i = 0; i < 16; ++i) { const float v = acc[nb][i] * rs; ss = fmaf(v, v, ss); }
      ss += xor32(ss);
      const float r = rsqrtf(ss * (1.f / 128.f) + EPS) * rs;
      bf16_t* dst = hb + E_CKV + (size_t)m * 128;
#pragma unroll
      for (int nb = 0; nb < 4; ++nb) {
#pragma unroll
        for (int pq = 0; pq < 2; ++pq) {
          const int c = 32 * nb + 8 * (2 * pq + h);
          float v[8];
          swap8(acc[nb], pq, v);
          stage_put(sreg, m & 31, 4 * (nb & 1) + 2 * pq + h, pk8(v, r, b_ckvg + c));
        }
        if (nb & 1) stage_flush(sreg, dst - (size_t)(m & 31) * 128 + 64 * (nb >> 1), 128);
      }
    } else {
      float* dst = (float*)(hb + E_KR) + (size_t)m * 32;
#pragma unroll
      for (int g = 0; g < 4; ++g) {
        f32x4 v = {acc[0][4 * g] * rs, acc[0][4 * g + 1] * rs, acc[0][4 * g + 2] * rs, acc[0][4 * g + 3] * rs};
        *(f32x4*)(dst + 8 * g + 4 * h) = v;
      }
    }
  }
};

DI void sincos_cw(float x, float& sn, float& cs) {
  const float k = rintf(x * 0.63661977236758134f);
  float r = fmaf(-k, 1.57079637050628662109375f, x);
  r = fmaf(-k, -4.37113900018624283e-8f, r);
  const int q = (int)k;
  const float r2 = r * r;
  const float sp = fmaf(r * r2, fmaf(r2, fmaf(r2, -1.9515295891e-4f, 8.3321608736e-3f), -1.6666654611e-1f), r);
  const float cp = fmaf(r2 * r2, fmaf(r2, fmaf(r2, 2.443315711809948e-5f, -1.388731625493765e-3f), 4.166664568298827e-2f), fmaf(r2, -0.5f, 1.f));
  const float s0 = (q & 1) ? cp : sp, c0 = (q & 1) ? sp : cp;
  sn = (q & 2) ? -s0 : s0;
  cs = ((q + 1) & 2) ? -c0 : c0;
}
DI constexpr float rope_inv(int i) {
  return i == 0 ? 1.f : i == 1 ? 0.5623413251903491f : i == 2 ? 0.31622776601683794f : i == 3 ? 0.1778279410038923f : i == 4 ? 0.1f
       : i == 5 ? 0.05623413251903491f : i == 6 ? 0.031622776601683794f : i == 7 ? 0.01778279410038923f : i == 8 ? 0.01f
       : i == 9 ? 0.005623413251903491f : i == 10 ? 0.0031622776601683794f : i == 11 ? 0.001778279410038923f : i == 12 ? 0.001f
       : i == 13 ? 0.0005623413251903491f : i == 14 ? 0.00031622776601683794f : 0.0001778279410038923f;
}
DI void rope4(const float (&y1)[4], const float (&y2)[4], int gg, int h, float posf, float (&o1)[4], float (&o2)[4]) {
#pragma unroll
  for (int e = 0; e < 4; ++e) {
    const float inv = h ? rope_inv(8 * gg + 4 + e) : rope_inv(8 * gg + e);
    const float ang = posf * inv;
    float sn, cs;
    sincos_cw(ang, sn, cs);
    o1[e] = y1[e] * cs - y2[e] * sn;
    o2[e] = y1[e] * sn + y2[e] * cs;
  }
}

struct EpiUQ {
  bf16_t* QB; const float* b_qg; const int* pos;
  DI void operator()(f32x16 (&acc)[4], int m, int nt, int h, float rs) const {
    const int b = m >> 13, s = m & (S - 1);
    float ss = 0.f;
#pragma unroll
    for (int nb = 0; nb < 3; ++nb)
#pragma unroll
      for (int i = 0; i < 16; ++i) { const float v = acc[nb][i] * rs; ss = fmaf(v, v, ss); }
    ss += xor32(ss);
    const float r = rsqrtf(ss * (1.f / 96.f) + EPS) * rs * QS_96;
    bf16_t* dst = QB + ((size_t)(b * 8 + nt) * S + s) * 96;
#pragma unroll
    for (int nb = 0; nb < 2; ++nb)
#pragma unroll
      for (int pq = 0; pq < 2; ++pq) {
        const int c = 32 * nb + 8 * (2 * pq + h);
        float v[8];
        swap8(acc[nb], pq, v);
        st8(dst + c, v, r, b_qg + c);
      }
    const float posf = (float)pos[m];
#pragma unroll
    for (int gg = 0; gg < 2; ++gg) {
      const int ri0 = 8 * gg + 4 * h;
      const f32x4 g1 = *(const f32x4*)(b_qg + 64 + ri0), g2 = *(const f32x4*)(b_qg + 80 + ri0);
      float y1[4], y2[4], o1[4], o2[4];
#pragma unroll
      for (int e = 0; e < 4; ++e) { y1[e] = acc[2][4 * gg + e] * r * g1[e]; y2[e] = acc[2][4 * gg + 8 + e] * r * g2[e]; }
      rope4(y1, y2, gg, h, posf, o1, o2);
      st4(dst + 64 + ri0, o1[0], o1[1], o1[2], o1[3]);
      st4(dst + 80 + ri0, o2[0], o2[1], o2[2], o2[3]);
    }
  }
};

struct EpiUKV {
  bf16_t *KB, *VB; const float* KR; const float* b_kg; const int* pos;
  DI void operator()(f32x16 (&acc)[4], int m, int nt, int h, float) const {
    const int b = m >> 13, s = m & (S - 1);
    f32x4 k1[2], k2[2];
    float ss = 0.f;
#pragma unroll
    for (int gg = 0; gg < 2; ++gg) {
      k1[gg] = *(const f32x4*)(KR + (size_t)m * 32 + 8 * gg + 4 * h);
      k2[gg] = *(const f32x4*)(KR + (size_t)m * 32 + 16 + 8 * gg + 4 * h);
#pragma unroll
      for (int e = 0; e < 4; ++e) { ss = fmaf(k1[gg][e], k1[gg][e], ss); ss = fmaf(k2[gg][e], k2[gg][e], ss); }
    }
#pragma unroll
    for (int nb = 0; nb < 2; ++nb)
#pragma unroll
      for (int i = 0; i < 16; ++i) ss = fmaf(acc[nb][i], acc[nb][i], ss);
    ss += xor32(ss);
    const float r = rsqrtf(ss * (1.f / 96.f) + EPS);
    bf16_t* dst = KB + ((size_t)(b * 8 + nt) * S + s) * 96;
#pragma unroll
    for (int nb = 0; nb < 2; ++nb)
#pragma unroll
      for (int pq = 0; pq < 2; ++pq) {
        const int c = 32 * nb + 8 * (2 * pq + h);
        float v[8];
        swap8(acc[nb], pq, v);
        st8(dst + c, v, r, b_kg + c);
      }
    const float posf = (float)pos[m];
#pragma unroll
    for (int gg = 0; gg < 2; ++gg) {
      const int ri0 = 8 * gg + 4 * h;
      const f32x4 g1 = *(const f32x4*)(b_kg + 64 + ri0), g2 = *(const f32x4*)(b_kg + 80 + ri0);
      float y1[4], y2[4], o1[4], o2[4];
#pragma unroll
      for (int e = 0; e < 4; ++e) { y1[e] = k1[gg][e] * r * g1[e]; y2[e] = k2[gg][e] * r * g2[e]; }
      rope4(y1, y2, gg, h, posf, o1, o2);
      st4(dst + 64 + ri0, o1[0], o1[1], o1[2], o1[3]);
      st4(dst + 80 + ri0, o2[0], o2[1], o2[2], o2[3]);
    }
    bf16_t* vd = VB + ((size_t)(b * 8 + nt) * S + s) * 64;
#pragma unroll
    for (int nb = 2; nb < 4; ++nb)
#pragma unroll
      for (int pq = 0; pq < 2; ++pq) {
        float v[8];
        swap8(acc[nb], pq, v);
        st8(vd + 32 * (nb - 2) + 8 * (2 * pq + h), v, 1.f, nullptr);
      }
  }
};

struct EpiOddIn {
  bf16_t* hb; const float *d_qg, *d_kg; unsigned char* lds;
  DI void operator()(f32x16 (&acc)[4], int m, int nt, int h, float rs) const {
    const int b = m >> 13, s = m & (S - 1);
    unsigned char* sreg = lds + EPI_LDS + (opaque_tid() >> 6) * 4096;
    const int region = nt >> 2, r4 = nt & 3;
    if (region < 5) {
#pragma unroll
      for (int hh = 0; hh < 2; ++hh) {
        float r = rs;
        const float* gain = nullptr;
        bf16_t* dst;
        if (region < 3) {
          if (region == 0) r *= QS_64;
          dst = hb + (size_t)region * (TE * 512) + ((size_t)(b * 8 + 2 * r4 + hh) * S + s) * 64;
        } else {
          float ss = 0.f;
#pragma unroll
          for (int x = 0; x < 2; ++x)
#pragma unroll
            for (int i = 0; i < 16; ++i) { const float v = acc[2 * hh + x][i] * rs; ss = fmaf(v, v, ss); }
          ss += xor32(ss);
          r = rsqrtf(ss * (1.f / 64.f) + EPS) * rs;
          if (region == 3) { gain = d_qg + hh * 64; r *= QS_64; } else gain = d_kg + hh * 64;
          dst = hb + (size_t)region * (TE * 512) + ((size_t)((b * 4 + r4) * 2 + hh) * S + s) * 64;
        }
#pragma unroll
        for (int x = 0; x < 2; ++x)
#pragma unroll
          for (int pq = 0; pq < 2; ++pq) {
            const int d = 32 * x + 8 * (2 * pq + h);
            float v[8];
            swap8(acc[2 * hh + x], pq, v);
            stage_put(sreg, m & 31, 4 * x + 2 * pq + h, pk8(v, r, gain ? gain + d : nullptr));
          }
        stage_flush(sreg, dst - (m & 31) * 64, 64);
      }
    } else {
      bf16_t* dst = hb + O_VD + ((size_t)(b * 4 + r4) * S + s) * 128;
#pragma unroll
      for (int nb = 0; nb < 4; ++nb) {
#pragma unroll
        for (int pq = 0; pq < 2; ++pq) {
          float v[8];
          swap8(acc[nb], pq, v);
          stage_put(sreg, m & 31, 4 * (nb & 1) + 2 * pq + h, pk8(v, rs, nullptr));
        }
        if (nb & 1) stage_flush(sreg, dst - (size_t)(m & 31) * 128 + 64 * (nb >> 1), 128);
      }
    }
  }
};

template <int DQK, int DV>
struct AL {
  static constexpr int KSTR = DQK * 2 + 16, VSTR = DV * 2 + 64, KBYTES = 64 * KSTR, VBYTES = 64 * VSTR, STAGE = KBYTES + VBYTES;
  static constexpr int KCH = DQK / 8, VCH = DV / 8;
  static constexpr int NKC = 8 * DQK, NVC = 8 * DV;
  static constexpr int NKR = (NKC + NT - 1) / NT, NVR = (NVC + NT - 1) / NT;
};

template <int DQK, int DV>
DI void a_gload(const bf16_t* Kt, const bf16_t* Vt, u32x4 (&rk)[AL<DQK, DV>::NKR], u32x4 (&rv)[AL<DQK, DV>::NVR], int tid) {
  typedef AL<DQK, DV> L;
#pragma unroll
  for (int q = 0; q < L::NKR; ++q) {
    const int c = tid + NT * q;
    if (c < L::NKC) rk[q] = *(const u32x4*)(Kt + (size_t)c * 8);
  }
#pragma unroll
  for (int q = 0; q < L::NVR; ++q) {
    const int c = tid + NT * q;
    if (c < L::NVC) rv[q] = *(const u32x4*)(Vt + (size_t)c * 8);
  }
}
template <int DQK, int DV>
DI void a_swrite(unsigned char* kl, unsigned char* vl, const u32x4 (&rk)[AL<DQK, DV>::NKR], const u32x4 (&rv)[AL<DQK, DV>::NVR], int tid) {
  typedef AL<DQK, DV> L;
#pragma unroll
  for (int q = 0; q < L::NKR; ++q) {
    const int c = tid + NT * q, row = c / L::KCH, cc = c - row * L::KCH;
    if (c < L::NKC) *(u32x4*)(kl + row * L::KSTR + cc * 16) = rk[q];
  }
#pragma unroll
  for (int q = 0; q < L::NVR; ++q) {
    const int c = tid + NT * q, row = c / L::VCH, cc = c - row * L::VCH;
    if (c < L::NVC) *(u32x4*)(vl + row * L::VSTR + cc * 16) = rv[q];
  }
}

template <int DV, int VSTR>
DI void v_load(const unsigned char* vl, int kb, int lane, bf16x8 (&vf)[2][DV / 32]) {
  const int h = lane >> 5, blk = (lane >> 4) & 1, q = (lane & 15) >> 2, pp = lane & 3;
  const unsigned char* a0 = vl + (32 * kb + 4 * h + q) * VSTR + (16 * blk + 4 * pp) * 2;
#pragma unroll
  for (int s2 = 0; s2 < 2; ++s2)
#pragma unroll
    for (int db = 0; db < DV / 32; ++db) {
      const unsigned char* a = a0 + 16 * s2 * VSTR + 64 * db;
      const s16x4 lo = __builtin_amdgcn_ds_read_tr16_b64_v4i16((LDS_AS s16x4*)(a));
      const s16x4 hi = __builtin_amdgcn_ds_read_tr16_b64_v4i16((LDS_AS s16x4*)(a + 8 * VSTR));
      vf[s2][db] = __builtin_shufflevector(lo, hi, 0, 1, 2, 3, 4, 5, 6, 7);
    }
}
template <int DV>
DI void pv_mma(const f32x16& p, const bf16x8 (&vf)[2][DV / 32], f32x16 (&O)[DV / 32]) {
#pragma unroll
  for (int s2 = 0; s2 < 2; ++s2) {
    const bf16x8 pf = pack8(p, 8 * s2);
#pragma unroll
    for (int db = 0; db < DV / 32; ++db) O[db] = MFMA(vf[s2][db], pf, O[db]);
  }
}

template <int MODE>
DI void attn_unit(const bf16_t* Qs, const bf16_t* Ks, const bf16_t* Vs, const bf16_t* Qs2, const bf16_t* Ks2, int qi, float slope2, float m0init,
                  float lam, float outscale, const float* subln, bf16_t* mixdst, float* stash, unsigned char* lds, float bnd0 = 0.f, float bnd1 = 0.f) {
  constexpr int DQK = (MODE == 1) ? 96 : 64, DV = (MODE == 3) ? 128 : 64, NDB = DV / 32, NKS = DQK / 16;
  typedef AL<DQK, DV> L;
  const int tid = opaque_tid(), lane = tid & 63, w = tid >> 6, h = lane >> 5, r = lane & 31;
  const int q0 = qi * 256;
  const int qrow = q0 + 32 * w + r;
  const int cw = (q0 + 32 * w) >> 6;
  const int gbw = (q0 + 32 * w) >> 5;
  const int jhi = 4 * qi + 3;
  int jlo = 0;
  if (MODE == 0) jlo = (4 * qi - 2) > 0 ? (4 * qi - 2) : 0;
  const int ntl = jhi - jlo + 1;
  constexpr int NPASS = (MODE == 3) ? 2 : 1;
#pragma unroll
  for (int pass = 0; pass < NPASS; ++pass) {
    const bf16_t* Qp = pass ? Qs2 : Qs;
    const bf16_t* Kp = pass ? Ks2 : Ks;
    bf16x8 qf[NKS];
#pragma unroll
    for (int s = 0; s < NKS; ++s) qf[s] = *(const bf16x8*)(Qp + (size_t)qrow * DQK + 16 * s + 8 * h);
    f32x16 O[NDB];
#pragma unroll
    for (int db = 0; db < NDB; ++db) O[db] = zero16();
    float m = (MODE == 0) ? m0init : -1e30f;
    float l = (MODE == 0 && h == 0) ? 1.f : 0.f;
    float c = 0.f;
    u32x4 rk[L::NKR], rv[L::NVR];
    {
      const int j0 = (MODE >= 2) ? jhi : jlo;
      a_gload<DQK, DV>(Kp + (size_t)j0 * 64 * DQK, Vs + (size_t)j0 * 64 * DV, rk, rv, tid);
      a_swrite<DQK, DV>(lds, lds + L::KBYTES, rk, rv, tid);
    }
    __builtin_amdgcn_s_waitcnt(0x0F70);
    __syncthreads();
    for (int it = 0; it < ntl; ++it) {
      const int j = (MODE >= 2) ? jhi - it : jlo + it;
      const bool more = it + 1 < ntl;
      if (more) {
        const int jn = (MODE >= 2) ? j - 1 : j + 1;
        a_gload<DQK, DV>(Kp + (size_t)jn * 64 * DQK, Vs + (size_t)jn * 64 * DV, rk, rv, tid);
      }
      const unsigned char* kl = lds + (it & 1) * L::STAGE;
      const unsigned char* vl = kl + L::KBYTES;
      if (MODE != 2) {
        const bool ok = (j <= cw) && (MODE != 0 || j >= cw - 2);
        if (ok && DV == 64) {
          f32x16 sc0 = zero16(), sc1 = zero16();
          bf16x8 vfa[2][NDB], vfb[2][NDB];
          {
            const unsigned char* kp = kl + r * L::KSTR + 16 * h;
            bf16x8 kf[NKS], kg[NKS];
#pragma unroll
            for (int s = 0; s < NKS; ++s) kf[s] = *(const bf16x8*)(kp + 32 * s);
            __builtin_amdgcn_sched_barrier(0);
#pragma unroll
            for (int s = 0; s < NKS; ++s) kg[s] = *(const bf16x8*)(kp + 32 * L::KSTR + 32 * s);
            __builtin_amdgcn_sched_barrier(0);
#pragma unroll
            for (int s = 0; s < NKS; ++s) sc0 = MFMA(kf[s], qf[s], sc0);
            __builtin_amdgcn_sched_barrier(0);
            v_load<DV, L::VSTR>(vl, 0, lane, vfa);
            v_load<DV, L::VSTR>(vl, 1, lane, vfb);
            __builtin_amdgcn_sched_barrier(0);
#pragma unroll
            for (int s = 0; s < NKS; ++s) sc1 = MFMA(kg[s], qf[s], sc1);
            __builtin_amdgcn_sched_barrier(0);
          }
          if (MODE == 0) {
            const float fl = (float)(qrow - (64 * j + 4 * h));
#pragma unroll
            for (int i = 0; i < 16; ++i) {
              sc0[i] = fmaf(-slope2, fabsf(fl - (float)((i & 3) + 8 * (i >> 2))), sc0[i]);
              sc1[i] = fmaf(-slope2, fabsf(fl - (float)(32 + (i & 3) + 8 * (i >> 2))), sc1[i]);
            }
          }
          float mx = fmaxf(sc0[0], sc1[0]);
#pragma unroll
          for (int i = 1; i < 16; ++i) mx = fmaxf(mx, fmaxf(sc0[i], sc1[i]));
          mx = fmaxf(mx, xor32(mx));
          const float mn = fmaxf(m, mx);
          if (__any(mn > m)) {
            const float alpha = ex2(m - mn);
            l *= alpha;
#pragma unroll
            for (int db = 0; db < NDB; ++db) O[db] = O[db] * alpha;
          }
          m = mn;
          float ps = 0.f;
#pragma unroll
          for (int i = 0; i < 16; ++i) { const float pe = ex2(sc0[i] - mn); sc0[i] = pe; ps += pe; }
          pv_mma<DV>(sc0, vfa, O);
#pragma unroll
          for (int i = 0; i < 16; ++i) { const float pe = ex2(sc1[i] - mn); sc1[i] = pe; ps += pe; }
          l += ps;
          pv_mma<DV>(sc1, vfb, O);
        } else if (ok) {
#pragma unroll 1
          for (int kb = 0; kb < 2; ++kb) {
            const unsigned char* kp = kl + (32 * kb + r) * L::KSTR + 16 * h;
            bf16x8 kf[NKS];
#pragma unroll
            for (int s = 0; s < NKS; ++s) kf[s] = *(const bf16x8*)(kp + 32 * s);
            bf16x8 vf[2][NDB];
            v_load<DV, L::VSTR>(vl, kb, lane, vf);
            __builtin_amdgcn_sched_barrier(0);
            f32x16 sc = zero16();
#pragma unroll
            for (int s = 0; s < NKS; ++s) sc = MFMA(kf[s], qf[s], sc);
            if (MODE == 0 || MODE == 3) {
              const float fl = (float)(qrow - (64 * j + 32 * kb + 4 * h));
#pragma unroll
              for (int i = 0; i < 16; ++i) sc[i] = fmaf(-slope2, fabsf(fl - (float)((i & 3) + 8 * (i >> 2))), sc[i]);
            }
            float mx = sc[0];
#pragma unroll
            for (int i = 1; i < 16; ++i) mx = fmaxf(mx, sc[i]);
            mx = fmaxf(mx, xor32(mx));
            const float mn = fmaxf(m, mx);
            if (__any(mn > m)) {
              const float alpha = ex2(m - mn);
              l *= alpha;
#pragma unroll
              for (int db = 0; db < NDB; ++db) O[db] = O[db] * alpha;
            }
            m = mn;
            float ps = 0.f;
#pragma unroll
            for (int i = 0; i < 16; ++i) { const float pe = ex2(sc[i] - mn); sc[i] = pe; ps += pe; }
            l += ps;
            pv_mma<DV>(sc, vf, O);
          }
        }
      } else {
#pragma unroll 1
        for (int kk = 0; kk < 2; ++kk) {
          const int kb = 1 - kk;
          const int gb = 2 * j + kb;
          if (gb <= gbw) {
            const bool diag = gb == gbw;
            const unsigned char* kp = kl + (32 * kb + r) * L::KSTR + 16 * h;
            bf16x8 kf[NKS];
#pragma unroll
            for (int s = 0; s < NKS; ++s) kf[s] = *(const bf16x8*)(kp + 32 * s);
            bf16x8 vf[2][NDB];
            v_load<DV, L::VSTR>(vl, kb, lane, vf);
            __builtin_amdgcn_sched_barrier(0);
            f32x16 z = zero16();
#pragma unroll
            for (int s = 0; s < NKS; ++s) z = MFMA(kf[s], qf[s], z);
            f32x16 sp;
#pragma unroll
            for (int i = 0; i < 16; ++i) {
              const float zi = z[i];
              const float e = ex2(-fabsf(zi));
              float v = fmaxf(zi, 0.f) + lg2(1.f + e);
              const int key = (i & 3) + 8 * (i >> 2) + 4 * h;
              if (diag && key >= r) v = 0.f;
              sp[i] = v;
            }
            float Tg[4], Tp[4], offs[4];
#pragma unroll
            for (int g = 0; g < 4; ++g) { Tg[g] = (sp[4 * g] + sp[4 * g + 1]) + (sp[4 * g + 2] + sp[4 * g + 3]); Tp[g] = xor32(Tg[g]); }
            float run = 0.f;
#pragma unroll
            for (int g = 3; g >= 0; --g) { offs[g] = run + (h == 0 ? Tp[g] : 0.f); run += Tg[g] + Tp[g]; }
#pragma unroll
            for (int g = 3; g >= 0; --g) {
              float a = c + offs[g];
#pragma unroll
              for (int e = 3; e >= 0; --e) {
                const int i = 4 * g + e;
                a += sp[i];
                float pe = ex2(z[i] - a);
                const int key = (i & 3) + 8 * (i >> 2) + 4 * h;
                if (diag && key >= r) pe = 0.f;
                z[i] = pe;
              }
            }
            c += run;
            pv_mma<DV>(z, vf, O);
          }
        }
      }
      if (more) {
        unsigned char* kn = lds + ((it + 1) & 1) * L::STAGE;
        a_swrite<DQK, DV>(kn, kn + L::KBYTES, rk, rv, tid);
      }
      if (MODE == 3) {
        volatile int* fl = (volatile int*)(lds + LDS_TILE_BYTES) + (it & 1) * 8;
        const float dmin = (float)((q0 + 32 * w) - (64 * j - 1));
        const float bnd = pass ? bnd1 : bnd0;
        const int done = __all(bnd - slope2 * dmin < m - 150.f) ? 1 : 0;
        if (lane == 0) fl[w] = done;
        __syncthreads();
        if (fl[0] + fl[1] + fl[2] + fl[3] + fl[4] + fl[5] + fl[6] + fl[7] == 8) break;
      } else if (MODE == 2) {
        volatile int* fl = (volatile int*)(lds + LDS_TILE_BYTES) + (it & 1) * 8;
        const int done = __all(c > 160.f) ? 1 : 0;
        if (lane == 0) fl[w] = done;
        __syncthreads();
        if (fl[0] + fl[1] + fl[2] + fl[3] + fl[4] + fl[5] + fl[6] + fl[7] == 8) break;
      } else
        __syncthreads();
    }
    bf16_t* orow = mixdst + (size_t)(32 * w + r) * DM;
    if (MODE == 2) {
#pragma unroll
      for (int db = 0; db < NDB; ++db)
#pragma unroll
        for (int pq = 0; pq < 2; ++pq) {
          float v[8];
          swap8(O[db], pq, v);
          st8(orow + 32 * db + 8 * (2 * pq + h), v, 1.f, nullptr);
        }
    } else {
      const float lt = l + xor32(l);
      const float inv = 1.f / lt;
      if (MODE != 3) {
#pragma unroll
        for (int db = 0; db < NDB; ++db)
#pragma unroll
          for (int pq = 0; pq < 2; ++pq) {
            float v[8];
            swap8(O[db], pq, v);
            st8(orow + 32 * db + 8 * (2 * pq + h), v, inv, nullptr);
          }
      } else if (pass == 0) {
#pragma unroll
        for (int db = 0; db < NDB; ++db)
#pragma unroll
          for (int g = 0; g < 4; ++g) {
            f32x4 v = {O[db][4 * g] * inv, O[db][4 * g + 1] * inv, O[db][4 * g + 2] * inv, O[db][4 * g + 3] * inv};
            *(f32x4*)(stash + tid * 64 + db * 16 + 4 * g) = v;
          }
      } else {
        const float li = lam * inv;
        float ss = 0.f;
#pragma unroll
        for (int db = 0; db < NDB; ++db)
#pragma unroll
          for (int g = 0; g < 4; ++g) {
            const f32x4 o1 = *(const f32x4*)(stash + tid * 64 + db * 16 + 4 * g);
#pragma unroll
            for (int e = 0; e < 4; ++e) { const float v = o1[e] - li * O[db][4 * g + e]; O[db][4 * g + e] = v; ss = fmaf(v, v, ss); }
          }
        ss += xor32(ss);
        const float rr = rsqrtf(ss * (1.f / 128.f) + EPS) * outscale;
#pragma unroll
        for (int db = 0; db < NDB; ++db)
#pragma unroll
          for (int pq = 0; pq < 2; ++pq) {
            const int d = 32 * db + 8 * (2 * pq + h);
            float v[8];
            swap8(O[db], pq, v);
            st8(orow + d, v, rr, subln + d);
          }
      }
    }
  }
}

DI int next_unit(int* ctr, unsigned char* lds) {
  volatile int* slot = (volatile int*)(lds + LDS_TILE_BYTES + 64);
  if (threadIdx.x == 0) *slot = atomicAdd(ctr, 1);
  __syncthreads();
  const int u = *slot;
  __syncthreads();
  return u;
}

DI void attn_even(const Params& p, int j, int* ctr, unsigned char* lds) {
  bf16_t* hb = (bf16_t*)(p.ws + WS_HID);
  bf16_t* mix = (bf16_t*)(p.ws + WS_MIX);
  for (;;) {
    int u = next_unit(ctr, lds);
    if (u >= 2048) break;
    if (u < 1024) {
      const int qi = 31 - (u >> 5), b = (u >> 3) & 3, hd = u & 7;
      const size_t sl = (size_t)(b * 8 + hd) * S;
      attn_unit<1>(hb + E_QB + sl * 96, hb + E_KB + sl * 96, hb + E_VB + sl * 64, nullptr, nullptr, qi, 0.f, 0.f, 0.f, 0.f, nullptr,
                   mix + ((size_t)b * S + qi * 256) * DM + 512 + hd * 64, nullptr, lds);
    } else {
      u -= 1024;
      const int qi = 31 - (u >> 5), b = (u >> 3) & 3, hd = u & 7, g = hd >> 2;
      const size_t sl = (size_t)(b * 8 + hd) * S, slk = (size_t)(b * 2 + g) * S;
      const float slope2 = exp2f(-(float)(hd + 1)) * LOG2E;
      const float m0 = p.in[10][j * 8 + hd] * LOG2E;
      attn_unit<0>(hb + E_QA + sl * 64, hb + E_KA + slk * 64, hb + E_VA + slk * 64, nullptr, nullptr, qi, slope2, m0, 0.f, 0.f, nullptr,
                   mix + ((size_t)b * S + qi * 256) * DM + hd * 64, nullptr, lds);
    }
  }
}

DI void attn_odd(const Params& p, int j, int* ctr, unsigned char* lds) {
  bf16_t* hb = (bf16_t*)(p.ws + WS_HID);
  bf16_t* mix = (bf16_t*)(p.ws + WS_MIX);
  const float* lf = p.in[21] + j * 256;
  float d01 = 0.f, d23 = 0.f;
  for (int i = 0; i < 64; ++i) { d01 = fmaf(lf[i], lf[64 + i], d01); d23 = fmaf(lf[128 + i], lf[192 + i], d23); }
  const float lambda_init = 0.8f - 0.6f * expf(-0.3f * (float)(2 * j + 1));
  const float lam = expf(d01) - expf(d23) + lambda_init;
  float bnd[2];
  for (int wh = 0; wh < 2; ++wh) {
    float gq = 0.f, gk = 0.f;
    for (int i = 0; i < 64; ++i) { gq = fmaxf(gq, fabsf(p.in[19][j * 128 + wh * 64 + i])); gk = fmaxf(gk, fabsf(p.in[20][j * 128 + wh * 64 + i])); }
    bnd[wh] = 8.f * LOG2E * 1.01f * gq * gk;
  }
  for (;;) {
    int u = next_unit(ctr, lds);
    if (u >= 1536) break;
    if (u < 512) {
      const int qi = 31 - (u >> 4), b = (u >> 2) & 3, hd = u & 3;
      const size_t sl0 = (size_t)((b * 4 + hd) * 2) * S, slv = (size_t)(b * 4 + hd) * S;
      const float slope2 = exp2f(-2.f * (float)(hd + 1)) * LOG2E;
      attn_unit<3>(hb + O_QD + sl0 * 64, hb + O_KD + sl0 * 64, hb + O_VD + slv * 128, hb + O_QD + (sl0 + S) * 64, hb + O_KD + (sl0 + S) * 64, qi, slope2,
                   0.f, lam, 1.f - lambda_init, p.in[22] + j * 128, mix + ((size_t)b * S + qi * 256) * DM + 512 + hd * 128,
                   (float*)(p.ws + WS_STASH) + (size_t)blockIdx.x * 32768, lds, bnd[0], bnd[1]);
    } else {
      u -= 512;
      const int qi = 31 - (u >> 5), b = (u >> 3) & 3, hd = u & 7;
      const size_t sl = (size_t)(b * 8 + hd) * S;
      attn_unit<2>(hb + O_QC + sl * 64, hb + O_KC + sl * 64, hb + O_VC + sl * 64, nullptr, nullptr, qi, 0.f, 0.f, 0.f, 0.f, nullptr,
                   mix + ((size_t)b * S + qi * 256) * DM + hd * 64, nullptr, lds);
    }
  }
}

#define XB_TMO      128
#define XB_XCNT(j)  (256  + 64 * (j))
#define XB_XSUB(j)  (1280 + 64 * (j))
#define XB_XGEN(j)  (2304 + 64 * (j))
#define XB_TOP      3328
#define XB_TOPGEN   3392
#define XCD_BAR_WORDS 3456
#define XB_SPIN_CAP (1u << 22)
DI unsigned xb_ld(unsigned* p) { return __hip_atomic_load(p, __ATOMIC_RELAXED, __HIP_MEMORY_SCOPE_AGENT); }
DI unsigned xb_add(unsigned* p, unsigned v) { return __hip_atomic_fetch_add(p, v, __ATOMIC_RELAXED, __HIP_MEMORY_SCOPE_AGENT); }
DI unsigned xb_xcc_id() { return (unsigned)__builtin_amdgcn_s_getreg((3 << 11) | 20) & 0xFu; }
#define XB_SPIN(cond, bar) do { unsigned _sp = 0; while (cond) { __builtin_amdgcn_s_sleep(1); \
    if ((++_sp & 255u) == 0u) { if (xb_ld(&(bar)[XB_TMO])) break; if (_sp > XB_SPIN_CAP) { atomicAdd(&(bar)[XB_TMO], 1u); break; } } } } while (0)
struct XcdBarrier { unsigned* bar; unsigned x; volatile LDS_AS unsigned* st; };
DI XcdBarrier xcd_barrier_post(unsigned* bar, volatile LDS_AS unsigned* st) {
  XcdBarrier b; b.bar = bar; b.x = xb_xcc_id(); b.st = st;
  if (threadIdx.x == 0) (void)xb_add(&bar[XB_XCNT(b.x)], 1u);
  return b;
}
DI void xcd_barrier_complete(unsigned* bar, unsigned x, unsigned& nloc, unsigned& nx) {
  const unsigned G = gridDim.x * gridDim.y * gridDim.z;
  unsigned sum, cnt, mine, sp = 0u;
  for (;;) {
    sum = 0u; cnt = 0u; mine = 0u;
#pragma unroll
    for (unsigned j = 0; j < 16; ++j) { const unsigned c = xb_ld(&bar[XB_XCNT(j)]); sum += c; cnt += (c > 0u) ? 1u : 0u; mine = (j == x) ? c : mine; }
    if (sum == G) break;
    __builtin_amdgcn_s_sleep(1);
    if ((++sp & 255u) == 0u) { if (xb_ld(&bar[XB_TMO])) break; if (sp > XB_SPIN_CAP) { atomicAdd(&bar[XB_TMO], 1u); break; } }
  }
  nloc = mine > 0u ? mine : 1u; nx = cnt > 0u ? cnt : 1u;
}
DI void xcd_barrier(const XcdBarrier& b) {
  asm volatile("s_waitcnt vmcnt(0)" ::: "memory");
  __syncthreads();
  if (threadIdx.x == 0) {
    unsigned* bar = b.bar;
    __builtin_amdgcn_s_waitcnt(0);
    unsigned nloc = b.st[0], nx = b.st[1];
    if (nloc == 0u) { xcd_barrier_complete(bar, b.x, nloc, nx); b.st[0] = nloc; b.st[1] = nx; }
    const unsigned old = xb_add(&bar[XB_XSUB(b.x)], 1u);
    const unsigned gen = old / nloc;
    if (old + 1u == (gen + 1u) * nloc) {
      __builtin_amdgcn_fence(__ATOMIC_RELEASE, "agent");
      asm volatile("s_waitcnt vmcnt(0)" ::: "memory");
      const unsigned og = xb_add(&bar[XB_TOP], 1u);
      const unsigned tg = og / nx;
      if (og + 1u == (tg + 1u) * nx) xb_add(&bar[XB_TOPGEN], 1u);
      else XB_SPIN(xb_ld(&bar[XB_TOPGEN]) == tg, bar);
      __builtin_amdgcn_fence(__ATOMIC_ACQUIRE, "agent");
      xb_add(&bar[XB_XGEN(b.x)], 1u);
      asm volatile("s_waitcnt vmcnt(0)" ::: "memory");
    } else {
      XB_SPIN(xb_ld(&bar[XB_XGEN(b.x)]) == gen, bar);
      __builtin_amdgcn_fence(__ATOMIC_ACQUIRE, "agent");
      asm volatile("s_waitcnt vmcnt(0)" ::: "memory");
    }
  }
  __syncthreads();
}

enum { K_PRO = 0, K_IN_E, K_UP_E, K_ATT_E, K_IN_O, K_ATT_O, K_OUT, K_MLPUP, K_DOWN };

extern "C" __global__ void __launch_bounds__(512) fwd_kernel(Params p, int ph_lo, int ph_hi) {
  extern __shared__ __attribute__((aligned(16))) unsigned char lds[];
  cg::grid_group grid = cg::this_grid();
  volatile LDS_AS unsigned* xst = (volatile LDS_AS unsigned*)(lds + LDS_TILE_BYTES + 96);
  if (threadIdx.x == 0) { xst[0] = 0u; xst[1] = 0u; }
  __syncthreads();
  XcdBarrier gbar = xcd_barrier_post((unsigned*)(p.ws + WS_BAR), xst);
  unsigned char* wb = p.ws + WS_W;
  bf16_t* xb = (bf16_t*)(p.ws + WS_XB);
  bf16_t* mix = (bf16_t*)(p.ws + WS_MIX);
  bf16_t* hb = (bf16_t*)(p.ws + WS_HID);
  int* ctr = (int*)(p.ws + WS_CTR);
  const int* pos = (const int*)p.in[1];
  for (int ph = ph_lo; ph < ph_hi; ++ph) {
    int kind = K_PRO, L = 0;
    if (ph > 0) {
      const int q = ph - 1, pair = q / 11, rr = q - pair * 11;
      if (rr < 6) { L = 2 * pair; kind = rr == 0 ? K_IN_E : rr == 1 ? K_UP_E : rr == 2 ? K_ATT_E : rr == 3 ? K_OUT : rr == 4 ? K_MLPUP : K_DOWN; }
      else { L = 2 * pair + 1; kind = rr == 6 ? K_IN_O : rr == 7 ? K_ATT_O : rr == 8 ? K_OUT : rr == 9 ? K_MLPUP : K_DOWN; }
    }
    const int j = L >> 1;
    for (int rep = 0; rep < ((kind == PROBE_KIND) ? 2 : 1); ++rep) {
    if (kind == K_PRO) {
      prologue(p, lds);
    } else if (kind == K_IN_E) {
      EpiEvenIn e{hb, p.in[8] + j * 64, p.in[9] + j * 64, p.in[12] + j * 128, lds};
      gemm_phase<true>(xb, 1024, (const bf16_t*)(wb + W_IN_E) + (size_t)j * 1280 * 1024, 1024, 5, e, lds);
    } else if (kind == K_UP_E) {
      EpiUQ e1{hb + E_QB, p.in[15] + j * 96, pos};
      gemm_phase<true>(hb + E_CQ, 256, (const bf16_t*)(wb + W_UQ) + (size_t)j * 1024 * 256, 256, 4, e1, lds);
      EpiUKV e2{hb + E_KB, hb + E_VB, (const float*)(hb + E_KR), p.in[16] + j * 96, pos};
      gemm_phase<false>(hb + E_CKV, 128, (const bf16_t*)(wb + W_UKV) + (size_t)j * 1024 * 128, 128, 4, e2, lds);
    } else if (kind == K_ATT_E) {
      attn_even(p, j, ctr + L + 4 * rep, lds);
    } else if (kind == K_IN_O) {
      EpiOddIn e{hb, p.in[19] + j * 128, p.in[20] + j * 128, lds};
      gemm_phase<true>(xb, 1024, (const bf16_t*)(wb + W_IN_O) + (size_t)j * 3072 * 1024, 1024, 12, e, lds);
    } else if (kind == K_ATT_O) {
      attn_odd(p, j, ctr + L + 4 * rep, lds);
    } else if (kind == K_OUT || kind == K_DOWN) {
      const bool isout = kind == K_OUT;
      EpiResid e{(isout && L == 0) ? p.in[0] : nullptr, xb, (!isout && L == 3) ? p.out : nullptr, lds};
      const bf16_t* Bt = isout ? ((L & 1) ? (const bf16_t*)(wb + W_OUT_O) : (const bf16_t*)(wb + W_OUT_E)) + (size_t)j * 1024 * 1024
                               : (const bf16_t*)(wb + W_DN) + (size_t)L * 1024 * 4096;
      gemm_phase<false>(isout ? mix : hb, isout ? 1024 : 4096, Bt, isout ? 1024 : 4096, 4, e, lds);
    } else {
      EpiRelu2 e{hb, lds};
      gemm_phase<true>(xb, 1024, (const bf16_t*)(wb + W_UP) + (size_t)L * 4096 * 1024, 1024, 16, e, lds);
    }
    if (PROBE_KIND >= 0) __syncthreads();
    }
    if (ph + 1 < ph_hi) {
      if (ph == ph_lo) grid.sync();
      else xcd_barrier(gbar);
    }
  }
}

extern "C" void kernel_launch(void* const* d_in, const int* in_sizes, int n_in, void* d_out, int out_size, void* d_ws, size_t ws_size,
                              hipStream_t stream) {
  static int grid_blocks = 0;
  if (grid_blocks == 0) {
    if (n_in != 23 || out_size != T * DM || ws_size < WS_END) {
      fprintf(stderr, "kernel_launch: unexpected shapes (n_in %d out %d ws %zu need %zu)\n", n_in, out_size, ws_size, (size_t)WS_END);
      grid_blocks = -1;
      return;
    }
    int dev = 0, cus = 0, per_cu = 0;
    hipGetDevice(&dev);
    hipDeviceGetAttribute(&cus, hipDeviceAttributeMultiprocessorCount, dev);
    if (hipFuncSetAttribute((const void*)fwd_kernel, hipFuncAttributeMaxDynamicSharedMemorySize, LDS_BYTES) != hipSuccess)
      fprintf(stderr, "kernel_launch: hipFuncSetAttribute failed\n");
    hipOccupancyMaxActiveBlocksPerMultiprocessor(&per_cu, (const void*)fwd_kernel, NT, LDS_BYTES);
    if (per_cu > 1) per_cu = 1;
    if (per_cu < 1) { fprintf(stderr, "kernel_launch: occupancy query gave %d\n", per_cu); per_cu = 1; }
    grid_blocks = cus * per_cu;
  }
  if (grid_blocks < 0) return;
  Params p{};
  for (int i = 0; i < 23; ++i) p.in[i] = (const float*)d_in[i];
  p.out = (float*)d_out;
  p.ws = (unsigned char*)d_ws;
  if (hipMemsetAsync((char*)d_ws + WS_BAR, 0, 16384, stream) != hipSuccess) fprintf(stderr, "kernel_launch: memset of barrier words failed\n");
#if MULTI_LAUNCH
  for (int ph = 0; ph < NPHASE; ++ph) hipLaunchKernelGGL(fwd_kernel, dim3(grid_blocks), dim3(NT), LDS_BYTES, stream, p, ph, ph + 1);
#else
  int lo = 0, hi = NPHASE;
  void* args[] = {&p, &lo, &hi};
  hipError_t e = hipLaunchCooperativeKernel((const void*)fwd_kernel, dim3(grid_blocks), dim3(NT), args, LDS_BYTES, stream);
  if (e != hipSuccess) fprintf(stderr, "cooperative launch failed: %s (grid %d)\n", hipGetErrorString(e), grid_blocks);
#endif
}
```

```cpp
#include <hip/hip_runtime.h>
#include <hip/hip_cooperative_groups.h>
#include <cstdio>
#include <cstdint>
namespace cg = cooperative_groups;

#ifndef PROBE_KIND
#define PROBE_KIND -1
#endif
#ifndef MULTI_LAUNCH
#define MULTI_LAUNCH 0
#endif

typedef unsigned short bf16_t;
typedef short bf16x8 __attribute__((ext_vector_type(8)));
typedef short s16x4 __attribute__((ext_vector_type(4)));
typedef float f32x16 __attribute__((ext_vector_type(16)));
typedef float f32x4 __attribute__((ext_vector_type(4)));
typedef float f32x2 __attribute__((ext_vector_type(2)));
typedef __bf16 bf16x2_t __attribute__((ext_vector_type(2)));
typedef unsigned u32x2 __attribute__((ext_vector_type(2)));
typedef unsigned u32x4 __attribute__((ext_vector_type(4)));
#define DI __device__ __forceinline__
#define LDS_AS __attribute__((address_space(3)))

constexpr int T = 32768, S = 8192, DM = 1024, DFF = 4096;
constexpr float EPS = 1e-6f;
constexpr float LOG2E = 1.4426950408889634f;
constexpr int NPHASE = 23;
constexpr int NT = 512;
constexpr int LDS_TILE_BYTES = 147456;
constexpr int LDS_BYTES = LDS_TILE_BYTES + 128;

constexpr size_t MiB = 1024 * 1024;
constexpr size_t WS_XB = 0;
constexpr size_t WS_MIX = 64 * MiB;
constexpr size_t WS_HID = 128 * MiB;
constexpr size_t WS_W = 384 * MiB;
constexpr size_t W_IN_E = 0;
constexpr size_t W_UQ = W_IN_E + 2ull * 1280 * 1024 * 2;
constexpr size_t W_UKV = W_UQ + 2ull * 1024 * 256 * 2;
constexpr size_t W_OUT_E = W_UKV + 2ull * 1024 * 128 * 2;
constexpr size_t W_IN_O = W_OUT_E + 2ull * 1024 * 1024 * 2;
constexpr size_t W_OUT_O = W_IN_O + 2ull * 3072 * 1024 * 2;
constexpr size_t W_UP = W_OUT_O + 2ull * 1024 * 1024 * 2;
constexpr size_t W_DN = W_UP + 4ull * 4096 * 1024 * 2;
constexpr size_t W_END = W_DN + 4ull * 4096 * 1024 * 2;
constexpr size_t WS_CTR = WS_W + W_END;
constexpr size_t WS_BAR = WS_CTR + 256;
constexpr size_t WS_STASH = WS_BAR + 16384;
constexpr size_t WS_END = WS_STASH + 256ull * 131072;
constexpr size_t TE = (size_t)T;
constexpr size_t E_QA = 0, E_KA = E_QA + TE * 512, E_VA = E_KA + TE * 128, E_CQ = E_VA + TE * 128, E_CKV = E_CQ + TE * 256,
                 E_QB = E_CKV + TE * 128, E_KB = E_QB + TE * 768, E_VB = E_KB + TE * 768, E_KR = E_VB + TE * 512  ;
constexpr size_t O_QC = 0, O_KC = TE * 512, O_VC = TE * 1024, O_QD = TE * 1536, O_KD = TE * 2048, O_VD = TE * 2560;

struct Params {
  const float* in[23];
  float* out;
  unsigned char* ws;
};

DI unsigned pack2(float lo, float hi) {
  f32x2 f = {lo, hi};
  bf16x2_t b = __builtin_convertvector(f, bf16x2_t);
  return __builtin_bit_cast(unsigned, b);
}
DI void st4(bf16_t* p, float a, float b, float c, float d) {
  u32x2 v = {pack2(a, b), pack2(c, d)};
  *(u32x2*)p = v;
}
DI bf16x8 pack8(const f32x16& x, int o) {
  u32x4 v = {pack2(x[o], x[o + 1]), pack2(x[o + 2], x[o + 3]), pack2(x[o + 4], x[o + 5]), pack2(x[o + 6], x[o + 7])};
  return __builtin_bit_cast(bf16x8, v);
}
DI float ex2(float x) { return __builtin_amdgcn_exp2f(x); }
DI float lg2(float x) { return __builtin_amdgcn_logf(x); }
DI float xor32(float x) { return __shfl_xor(x, 32); }
#define MFMA(a, b, c) __builtin_amdgcn_mfma_f32_32x32x16_bf16((a), (b), (c), 0, 0, 0)
DI int opaque_tid() { int t = threadIdx.x; asm volatile("" : "+v"(t)); return t; }
DI f32x16 zero16() { f32x16 z; for (int i = 0; i < 16; ++i) z[i] = 0.f; return z; }

DI void tconv(const float* __restrict__ src, const float* __restrict__ gain, int N, int K, bf16_t* __restrict__ dst, int Npad, int grp,
              int grp_pad, unsigned char* lds) {
  const int tid5 = opaque_tid();
  const int half = tid5 >> 8, tid = tid5 & 255;
  float* tile = (float*)lds + half * (64 * 33);
  const int nkt = K >> 6, ntl = (Npad >> 5) * nkt;
  for (int tt = blockIdx.x; 2 * tt < ntl; tt += gridDim.x) {
    const int t = 2 * tt + half;
    const bool active = t < ntl;
    const int ntile = t / nkt, kt = t - ntile * nkt;
    const int np0 = ntile * 32, k0 = kt * 64;
    const int gi = np0 / grp_pad, go = np0 - gi * grp_pad;
    const int sn0 = gi * grp + go;
    const bool valid = active && (go < grp) && (sn0 < N);
    if (valid) {
#pragma unroll
      for (int p = 0; p < 2; ++p) {
        const int kk = (tid >> 3) + 32 * p, nn = (tid & 7) * 4;
        const f32x4 v = *(const f32x4*)(src + (size_t)(k0 + kk) * N + sn0 + nn);
        const float gsc = gain ? gain[k0 + kk] : 1.f;
#pragma unroll
        for (int e = 0; e < 4; ++e) tile[kk * 33 + nn + e] = v[e] * gsc;
      }
    }
    __syncthreads();
    if (active) {
      const int n = tid >> 3, kq = (tid & 7) * 8;
      u32x4 o = {0u, 0u, 0u, 0u};
      if (valid) {
        float f[8];
#pragma unroll
        for (int j = 0; j < 8; ++j) f[j] = tile[(kq + j) * 33 + n];
        o[0] = pack2(f[0], f[1]); o[1] = pack2(f[2], f[3]); o[2] = pack2(f[4], f[5]); o[3] = pack2(f[6], f[7]);
      }
      *(u32x4*)(dst + (size_t)(np0 + n) * K + k0 + kq) = o;
    }
    __syncthreads();
  }
}

DI void prologue(const Params& p, unsigned char* lds) {
  unsigned char* wb = p.ws + WS_W;
  if (blockIdx.x == 0 && threadIdx.x < 16) ((int*)(p.ws + WS_CTR))[threadIdx.x] = 0;
  {
    const float* x = p.in[0];
    bf16_t* xb = (bf16_t*)(p.ws + WS_XB);
    const size_t n8 = (size_t)T * DM / 8;
    for (size_t i = (size_t)blockIdx.x * NT + threadIdx.x; i < n8; i += (size_t)gridDim.x * NT) {
      const f32x4 a = *(const f32x4*)(x + i * 8), b = *(const f32x4*)(x + i * 8 + 4);
      u32x4 o = {pack2(a[0], a[1]), pack2(a[2], a[3]), pack2(b[0], b[1]), pack2(b[2], b[3])};
      *(u32x4*)(xb + i * 8) = o;
    }
  }
  for (int j = 0; j < 2; ++j) {
    tconv(p.in[6] + (size_t)j * 1024 * 1184, p.in[2] + (2 * j) * 1024, 1184, 1024, (bf16_t*)(wb + W_IN_E) + (size_t)j * 1280 * 1024, 1280, 1280, 1280, lds);
    tconv(p.in[13] + (size_t)j * 256 * 768, p.in[11] + j * 256, 768, 256, (bf16_t*)(wb + W_UQ) + (size_t)j * 1024 * 256, 1024, 96, 128, lds);
    tconv(p.in[14] + (size_t)j * 128 * 1024, nullptr, 1024, 128, (bf16_t*)(wb + W_UKV) + (size_t)j * 1024 * 128, 1024, 1024, 1024, lds);
    tconv(p.in[7] + (size_t)j * 1024 * 1024, nullptr, 1024, 1024, (bf16_t*)(wb + W_OUT_E) + (size_t)j * 1024 * 1024, 1024, 1024, 1024, lds);
    tconv(p.in[17] + (size_t)j * 1024 * 3072, p.in[2] + (2 * j + 1) * 1024, 3072, 1024, (bf16_t*)(wb + W_IN_O) + (size_t)j * 3072 * 1024, 3072, 3072, 3072, lds);
    tconv(p.in[18] + (size_t)j * 1024 * 1024, nullptr, 1024, 1024, (bf16_t*)(wb + W_OUT_O) + (size_t)j * 1024 * 1024, 1024, 1024, 1024, lds);
  }
  for (int L = 0; L < 4; ++L) {
    tconv(p.in[4] + (size_t)L * 1024 * 4096, p.in[3] + L * 1024, 4096, 1024, (bf16_t*)(wb + W_UP) + (size_t)L * 4096 * 1024, 4096, 4096, 4096, lds);
    tconv(p.in[5] + (size_t)L * 4096 * 1024, nullptr, 1024, 4096, (bf16_t*)(wb + W_DN) + (size_t)L * 1024 * 4096, 1024, 1024, 1024, lds);
  }
}

constexpr int G_OP = 256 * 64;
constexpr int G_STAGE = 2 * G_OP;
constexpr int G_NST = 4;
static_assert(G_NST * G_STAGE <= LDS_TILE_BYTES, "LDS ring");

DI void tile_map(int t, int Ntiles, int& mt, int& nt) {
  const int xcd = t & 7, j = t >> 3;
  const int per = 4 * Ntiles;
  const int g = j / per, r = j - g * per;
  nt = r >> 2;
  mt = (g * 4 + (r & 3)) * 8 + xcd;
}

template <bool ROWSS>
DI void frag_ss(const bf16x8& af, float& ss) {
  if (ROWSS) {
    typedef __bf16 bf2 __attribute__((ext_vector_type(2)));
    typedef __bf16 bf8 __attribute__((ext_vector_type(8)));
    const bf8 v = __builtin_bit_cast(bf8, af);
#pragma unroll
    for (int e = 0; e < 4; ++e) {
      const bf2 t = {v[2 * e], v[2 * e + 1]};
      ss = __builtin_amdgcn_fdot2_f32_bf16(t, t, ss, false);
    }
  }
}

DI void lds_barrier() {
  __builtin_amdgcn_s_waitcnt(0xC07F);
  __builtin_amdgcn_s_barrier();
  asm volatile("" ::: "memory");
}

template <bool ROWSS, class Epi>
DI void gemm_phase(const bf16_t* A, int lda, const bf16_t* Bt, int K, int Ntiles, const Epi& epi, unsigned char* lds) {
  const int tid = opaque_tid(), lane = tid & 63, w = tid >> 6, h = lane >> 5, r = lane & 31;
  const int wm = w & 3, wn = w >> 2;
  const int ntiles = (T / 256) * Ntiles;
  const int nk = K >> 5;
  const int fsw = (h ^ ((r >> 2) & 3)) * 16;
  const int a_off = (64 * wm + r) * 64 + fsw;
  const int b_off = G_OP + (128 * wn + r) * 64 + fsw;
  const int grow = lane >> 2, gch = ((lane & 3) ^ ((lane >> 4) & 3)) * 8;
  const int wu = __builtin_amdgcn_readfirstlane(w);
  int t = blockIdx.x;
  int m0 = 0, nt = 0;
  const bf16_t* ag = A;
  const bf16_t* bg = Bt;
  auto set_tile = [&](int tt) {
    int mt_;
    tile_map(tt, Ntiles, mt_, nt);
    m0 = mt_ * 256;
    ag = A + (size_t)(m0 + 16 * w + grow) * lda + gch;
    bg = Bt + (size_t)(nt * 256 + 16 * w + grow) * K + gch;
  };
  bool primed = false;
  while (t < ntiles) {
    auto glds1 = [&](int kt, int piece) {
      unsigned char* st = lds + (kt & (G_NST - 1)) * G_STAGE + wu * 1024;
      const int k0 = kt * 32;
      if (piece == 0) __builtin_amdgcn_global_load_lds((const unsigned*)(ag + k0), (unsigned*)(st), 16, 0, 0);
      if (piece == 1) __builtin_amdgcn_global_load_lds((const unsigned*)(ag + (size_t)128 * lda + k0), (unsigned*)(st + 8192), 16, 0, 0);
      if (piece == 2) __builtin_amdgcn_global_load_lds((const unsigned*)(bg + k0), (unsigned*)(st + G_OP), 16, 0, 0);
      if (piece == 3) __builtin_amdgcn_global_load_lds((const unsigned*)(bg + (size_t)128 * K + k0), (unsigned*)(st + G_OP + 8192), 16, 0, 0);
    };
    auto glds = [&](int kt) { glds1(kt, 0); glds1(kt, 1); glds1(kt, 2); glds1(kt, 3); };
    if (!primed) {
      set_tile(t);
      asm volatile("s_waitcnt vmcnt(0)" ::: "memory");
      glds(0); glds(1); glds(2);
      primed = true;
    }
    f32x16 acc[2][4];
#pragma unroll
    for (int mb = 0; mb < 2; ++mb)
#pragma unroll
      for (int nb = 0; nb < 4; ++nb) acc[mb][nb] = zero16();
    float ss0 = 0.f, ss1 = 0.f;
    bf16x8 af0[2], wf0[4], af1[2], wf1[4];
    for (int kt = 0; kt < nk; ++kt) {
      if (kt + 2 < nk) asm volatile("s_waitcnt vmcnt(4)" ::: "memory"); else asm volatile("s_waitcnt vmcnt(0)" ::: "memory");
      lds_barrier();
      const bool pf = kt + 3 < nk;
      const unsigned char* sc = lds + (kt & (G_NST - 1)) * G_STAGE;
      if (kt == 0) {
#pragma unroll
        for (int mb = 0; mb < 2; ++mb) af0[mb] = *(const bf16x8*)(sc + a_off + 2048 * mb);
#pragma unroll
        for (int nb = 0; nb < 4; ++nb) wf0[nb] = *(const bf16x8*)(sc + b_off + 2048 * nb);
      }
#pragma unroll
      for (int mb = 0; mb < 2; ++mb) af1[mb] = *(const bf16x8*)(sc + (a_off ^ 32) + 2048 * mb);
#pragma unroll
      for (int nb = 0; nb < 4; ++nb) wf1[nb] = *(const bf16x8*)(sc + (b_off ^ 32) + 2048 * nb);
      __builtin_amdgcn_sched_barrier(0);
      frag_ss<ROWSS>(af0[0], ss0);
      frag_ss<ROWSS>(af0[1], ss1);
#pragma unroll
      for (int nb = 0; nb < 4; ++nb) {
#pragma unroll
        for (int mb = 0; mb < 2; ++mb) acc[mb][nb] = MFMA(wf0[nb], af0[mb], acc[mb][nb]);
        if (nb == 1) { __builtin_amdgcn_sched_barrier(0); if (pf) glds1(kt + 3, 0); __builtin_amdgcn_sched_barrier(0); }
        if (nb == 3) { __builtin_amdgcn_sched_barrier(0); if (pf) glds1(kt + 3, 1); }
      }
      __builtin_amdgcn_sched_barrier(0);
      __builtin_amdgcn_sched_barrier(0);
      frag_ss<ROWSS>(af1[0], ss0);
      frag_ss<ROWSS>(af1[1], ss1);
#pragma unroll
      for (int nb = 0; nb < 4; ++nb) {
#pragma unroll
        for (int mb = 0; mb < 2; ++mb) acc[mb][nb] = MFMA(wf1[nb], af1[mb], acc[mb][nb]);
        if (nb == 0) {
          __builtin_amdgcn_sched_barrier(0);
          if (kt + 1 < nk) {
            const unsigned char* sn = lds + ((kt + 1) & (G_NST - 1)) * G_STAGE;
#pragma unroll
            for (int mb = 0; mb < 2; ++mb) af0[mb] = *(const bf16x8*)(sn + a_off + 2048 * mb);
#pragma unroll
            for (int nb2 = 0; nb2 < 4; ++nb2) wf0[nb2] = *(const bf16x8*)(sn + b_off + 2048 * nb2);
          }
          __builtin_amdgcn_sched_barrier(0);
        }
        if (nb == 1) { __builtin_amdgcn_sched_barrier(0); if (pf) glds1(kt + 3, 2); __builtin_amdgcn_sched_barrier(0); }
        if (nb == 3) { __builtin_amdgcn_sched_barrier(0); if (pf) glds1(kt + 3, 3); }
      }
      __builtin_amdgcn_sched_barrier(0);
    }
    lds_barrier();
    float rs0 = 1.f, rs1 = 1.f;
    if (ROWSS) {
      ss0 += xor32(ss0);
      ss1 += xor32(ss1);
      rs0 = rsqrtf(ss0 / (float)K + EPS);
      rs1 = rsqrtf(ss1 / (float)K + EPS);
    }
    const int mrow = m0 + 64 * wm + r, nt128 = 2 * nt + wn;
    t += gridDim.x;
    if (t < ntiles) { set_tile(t); glds(0); glds(1); glds(2); }
    epi(acc[0], mrow, nt128, h, rs0);
    epi(acc[1], mrow + 32, nt128, h, rs1);
  }
}

DI void swap8(const f32x16& a, int p, float (&v)[8]) {
#pragma unroll
  for (int e = 0; e < 4; ++e) {
    const auto r = __builtin_amdgcn_permlane32_swap(__float_as_uint(a[8 * p + e]), __float_as_uint(a[8 * p + 4 + e]), false, false);
    v[e] = __uint_as_float(r[0]);
    v[4 + e] = __uint_as_float(r[1]);
  }
}
DI u32x4 pk8(const float (&v)[8], float r, const float* gain) {
  float o[8];
  if (gain) {
    const f32x4 g0 = *(const f32x4*)(gain), g1 = *(const f32x4*)(gain + 4);
#pragma unroll
    for (int e = 0; e < 4; ++e) { o[e] = v[e] * r * g0[e]; o[4 + e] = v[4 + e] * r * g1[e]; }
  } else {
#pragma unroll
    for (int e = 0; e < 8; ++e) o[e] = v[e] * r;
  }
  return (u32x4){pack2(o[0], o[1]), pack2(o[2], o[3]), pack2(o[4], o[5]), pack2(o[6], o[7])};
}
DI void st8(bf16_t* p, const float (&v)[8], float r, const float* gain) {
  float o[8];
  if (gain) {
    const f32x4 g0 = *(const f32x4*)(gain), g1 = *(const f32x4*)(gain + 4);
#pragma unroll
    for (int e = 0; e < 4; ++e) { o[e] = v[e] * r * g0[e]; o[4 + e] = v[4 + e] * r * g1[e]; }
  } else {
#pragma unroll
    for (int e = 0; e < 8; ++e) o[e] = v[e] * r;
  }
  u32x4 u = {pack2(o[0], o[1]), pack2(o[2], o[3]), pack2(o[4], o[5]), pack2(o[6], o[7])};
  *(u32x4*)p = u;
}
constexpr int EPI_LDS = 3 * G_STAGE;
DI void stage_put(unsigned char* reg, int r, int chunk, const u32x4& o) { *(u32x4*)(reg + r * 128 + ((chunk ^ (r & 7)) << 4)) = o; }
DI void stage_flush(unsigned char* reg, bf16_t* dst0, size_t ld) {
  const int lane = opaque_tid() & 63;
  __builtin_amdgcn_s_waitcnt(0xC07F);
#pragma unroll
  for (int q = 0; q < 4; ++q) {
    const int row = 8 * q + (lane >> 3), phys = lane & 7;
    const u32x4 v = *(const u32x4*)(reg + row * 128 + (phys << 4));
    *(u32x4*)(dst0 + (size_t)row * ld + ((phys ^ (row & 7)) << 3)) = v;
  }
  __builtin_amdgcn_s_waitcnt(0xC07F);
  __builtin_amdgcn_sched_barrier(0);
}
struct EpiResid {
  const float* res_f32; bf16_t* xb; float* out_f32; unsigned char* lds;
  DI void operator()(f32x16 (&acc)[4], int m, int nt, int h, float) const {
    const size_t base = (size_t)m * DM + nt * 128;
    const int r = m & 31;
    unsigned char* reg = lds + EPI_LDS + (opaque_tid() >> 6) * 4096;
#pragma unroll
    for (int nb = 0; nb < 4; ++nb) {
#pragma unroll
      for (int p = 0; p < 2; ++p) {
        const int c = 32 * nb + 8 * (2 * p + h);
        float v[8];
        swap8(acc[nb], p, v);
        if (res_f32) {
          const f32x4 r0 = *(const f32x4*)(res_f32 + base + c), r1 = *(const f32x4*)(res_f32 + base + c + 4);
#pragma unroll
          for (int e = 0; e < 4; ++e) { v[e] += r0[e]; v[4 + e] += r1[e]; }
        } else {
          const u32x4 u = *(const u32x4*)(xb + base + c);
#pragma unroll
          for (int e = 0; e < 4; ++e) { v[2 * e] += __uint_as_float(u[e] << 16); v[2 * e + 1] += __uint_as_float(u[e] & 0xffff0000u); }
        }
        if (out_f32) {
          *(f32x4*)(out_f32 + base + c) = (f32x4){v[0], v[1], v[2], v[3]};
          *(f32x4*)(out_f32 + base + c + 4) = (f32x4){v[4], v[5], v[6], v[7]};
        } else {
          const u32x4 o = {pack2(v[0], v[1]), pack2(v[2], v[3]), pack2(v[4], v[5]), pack2(v[6], v[7])};
          stage_put(reg, r, 4 * (nb & 1) + 2 * p + h, o);
        }
      }
      if (!out_f32 && (nb & 1)) stage_flush(reg, xb + (size_t)(m - r) * DM + nt * 128 + 64 * (nb >> 1), DM);
    }
  }
};
struct EpiRelu2 {
  bf16_t* hid; unsigned char* lds;
  DI void operator()(f32x16 (&acc)[4], int m, int nt, int h, float rs) const {
    const int r = m & 31;
    unsigned char* reg = lds + EPI_LDS + (opaque_tid() >> 6) * 4096;
    bf16_t* blk = hid + (size_t)(m - r) * DFF + nt * 128;
#pragma unroll
    for (int ch = 0; ch < 2; ++ch) {
#pragma unroll
      for (int nb2 = 0; nb2 < 2; ++nb2)
#pragma unroll
        for (int p = 0; p < 2; ++p) {
          float v[8];
          swap8(acc[2 * ch + nb2], p, v);
#pragma unroll
          for (int e = 0; e < 8; ++e) { const float a = fmaxf(v[e] * rs, 0.f); v[e] = a * a; }
          const u32x4 o = {pack2(v[0], v[1]), pack2(v[2], v[3]), pack2(v[4], v[5]), pack2(v[6], v[7])};
          stage_put(reg, r, 4 * nb2 + 2 * p + h, o);
        }
      stage_flush(reg, blk + 64 * ch, DFF);
    }
  }
};
constexpr float QS_64 = 0.125f * LOG2E;
constexpr float QS_96 = 0.10206207261596575f * LOG2E;

struct EpiEvenIn {
  bf16_t* hb; const float *a_qg, *a_kg, *b_ckvg; unsigned char* lds;
  DI void operator()(f32x16 (&acc)[4], int m, int nt, int h, float rs) const {
    const int b = m >> 13, s = m & (S - 1);
    unsigned char* sreg = lds + EPI_LDS + (opaque_tid() >> 6) * 4096;
    if (nt < 6) {
#pragma unroll
      for (int hh = 0; hh < 2; ++hh) {
        float r = rs;
        const float* gain = nullptr;
        bf16_t* dst;
        if (nt < 5) {
          float ss = 0.f;
#pragma unroll
          for (int x = 0; x < 2; ++x)
#pragma unroll
            for (int i = 0; i < 16; ++i) { const float v = acc[2 * hh + x][i] * rs; ss = fmaf(v, v, ss); }
          ss += xor32(ss);
          r = rsqrtf(ss * (1.f / 64.f) + EPS) * rs;
          if (nt < 4) { gain = a_qg; r *= QS_64; } else gain = a_kg;
        }
        {
          const size_t off = (nt < 4) ? E_QA + ((size_t)(b * 8 + 2 * nt + hh) * S + s) * 64
                                      : E_KA + (size_t)(nt - 4) * (TE * 128) + ((size_t)(b * 2 + hh) * S + s) * 64;
          dst = hb + off;
        }
#pragma unroll
        for (int x = 0; x < 2; ++x)
#pragma unroll
          for (int pq = 0; pq < 2; ++pq) {
            const int d = 32 * x + 8 * (2 * pq + h);
            float v[8];
            swap8(acc[2 * hh + x], pq, v);
            stage_put(sreg, m & 31, 4 * x + 2 * pq + h, pk8(v, r, gain ? gain + d : nullptr));
          }
        stage_flush(sreg, dst - (m & 31) * 64, 64);
      }
    } else if (nt < 8) {
      bf16_t* dst = hb + E_CQ + (size_t)m * 256 + (nt - 6) * 128;
#pragma unroll
      for (int nb = 0; nb < 4; ++nb) {
#pragma unroll
        for (int pq = 0; pq < 2; ++pq) {
          float v[8];
          swap8(acc[nb], pq, v);
          stage_put(sreg, m & 31, 4 * (nb & 1) + 2 * pq + h, pk8(v, rs, nullptr));
        }
        if (nb & 1) stage_flush(sreg, dst - (size_t)(m & 31) * 256 + 64 * (nb >> 1), 256);
      }
    } else if (nt == 8) {
      float ss = 0.f;
#pragma unroll
      for (int nb = 0; nb < 4; ++nb)
#pragma unroll
        for (int i = 0; i < 16; ++i) { const float v = acc[nb][i] * rs; ss = fmaf(v, v, ss); }
      ss += xor32(ss);
      const float r = rsqrtf(ss * (1.f / 128.f) + EPS) * rs;
      bf16_t* dst = hb + E_CKV + (size_t)m * 128;
#pragma unroll
      for (int nb = 0; nb < 4; ++nb) {
#pragma unroll
        for (int pq = 0; pq < 2; ++pq) {
          const int c = 32 * nb + 8 * (2 * pq + h);
          float v[8];
          swap8(acc[nb], pq, v);
          stage_put(sreg, m & 31, 4 * (nb & 1) + 2 * pq + h, pk8(v, r, b_ckvg + c));
        }
        if (nb & 1) stage_flush(sreg, dst - (size_t)(m & 31) * 128 + 64 * (nb >> 1), 128);
      }
    } else {
      float* dst = (float*)(hb + E_KR) + (size_t)m * 32;
#pragma unroll
      for (int g = 0; g < 4; ++g) {
        f32x4 v = {acc[0][4 * g] * rs, acc[0][4 * g + 1] * rs, acc[0][4 * g + 2] * rs, acc[0][4 * g + 3] * rs};
        *(f32x4*)(dst + 8 * g + 4 * h) = v;
      }
    }
  }
};

DI void sincos_cw(float x, float& sn, float& cs) {
  const float k = rintf(x * 0.63661977236758134f);
  float r = fmaf(-k, 1.57079637050628662109375f, x);
  r = fmaf(-k, -4.37113900018624283e-8f, r);
  const int q = (int)k;
  const float r2 = r * r;
  const float sp = fmaf(r * r2, fmaf(r2, fmaf(r2, -1.9515295891e-4f, 8.3321608736e-3f), -1.6666654611e-1f), r);
  const float cp = fmaf(r2 * r2, fmaf(r2, fmaf(r2, 2.443315711809948e-5f, -1.388731625493765e-3f), 4.166664568298827e-2f), fmaf(r2, -0.5f, 1.f));
  const float s0 = (q & 1) ? cp : sp, c0 = (q & 1) ? sp : cp;
  sn = (q & 2) ? -s0 : s0;
  cs = ((q + 1) & 2) ? -c0 : c0;
}
DI constexpr float rope_inv(int i) {
  return i == 0 ? 1.f : i == 1 ? 0.5623413251903491f : i == 2 ? 0.31622776601683794f : i == 3 ? 0.1778279410038923f : i == 4 ? 0.1f
       : i == 5 ? 0.05623413251903491f : i == 6 ? 0.031622776601683794f : i == 7 ? 0.01778279410038923f : i == 8 ? 0.01f
       : i == 9 ? 0.005623413251903491f : i == 10 ? 0.0031622776601683794f : i == 11 ? 0.001778279410038923f : i == 12 ? 0.001f
       : i == 13 ? 0.0005623413251903491f : i == 14 ? 0.00031622776601683794f : 0.0001778279410038923f;
}
DI void rope4(const float (&y1)[4], const float (&y2)[4], int gg, int h, float posf, float (&o1)[4], float (&o2)[4]) {
#pragma unroll
  for (int e = 0; e < 4; ++e) {
    const float inv = h ? rope_inv(8 * gg + 4 + e) : rope_inv(8 * gg + e);
    const float ang = posf * inv;
    float sn, cs;
    sincos_cw(ang, sn, cs);
    o1[e] = y1[e] * cs - y2[e] * sn;
    o2[e] = y1[e] * sn + y2[e] * cs;
  }
}

struct EpiUQ {
  bf16_t* QB; const float* b_qg; const int* pos;
  DI void operator()(f32x16 (&acc)[4], int m, int nt, int h, float rs) const {
    const int b = m >> 13, s = m & (S - 1);
    float ss = 0.f;
#pragma unroll
    for (int nb = 0; nb < 3; ++nb)
#pragma unroll
      for (int i = 0; i < 16; ++i) { const float v = acc[nb][i] * rs; ss = fmaf(v, v, ss); }
    ss += xor32(ss);
    const float r = rsqrtf(ss * (1.f / 96.f) + EPS) * rs * QS_96;
    bf16_t* dst = QB + ((size_t)(b * 8 + nt) * S + s) * 96;
#pragma unroll
    for (int nb = 0; nb < 2; ++nb)
#pragma unroll
      for (int pq = 0; pq < 2; ++pq) {
        const int c = 32 * nb + 8 * (2 * pq + h);
        float v[8];
        swap8(acc[nb], pq, v);
        st8(dst + c, v, r, b_qg + c);
      }
    const float posf = (float)pos[m];
#pragma unroll
    for (int gg = 0; gg < 2; ++gg) {
      const int ri0 = 8 * gg + 4 * h;
      const f32x4 g1 = *(const f32x4*)(b_qg + 64 + ri0), g2 = *(const f32x4*)(b_qg + 80 + ri0);
      float y1[4], y2[4], o1[4], o2[4];
#pragma unroll
      for (int e = 0; e < 4; ++e) { y1[e] = acc[2][4 * gg + e] * r * g1[e]; y2[e] = acc[2][4 * gg + 8 + e] * r * g2[e]; }
      rope4(y1, y2, gg, h, posf, o1, o2);
      st4(dst + 64 + ri0, o1[0], o1[1], o1[2], o1[3]);
      st4(dst + 80 + ri0, o2[0], o2[1], o2[2], o2[3]);
    }
  }
};

struct EpiUKV {
  bf16_t *KB, *VB; const float* KR; const float* b_kg; const int* pos;
  DI void operator()(f32x16 (&acc)[4], int m, int nt, int h, float) const {
    const int b = m >> 13, s = m & (S - 1);
    f32x4 k1[2], k2[2];
    float ss = 0.f;
#pragma unroll
    for (int gg = 0; gg < 2; ++gg) {
      k1[gg] = *(const f32x4*)(KR + (size_t)m * 32 + 8 * gg + 4 * h);
      k2[gg] = *(const f32x4*)(KR + (size_t)m * 32 + 16 + 8 * gg + 4 * h);
#pragma unroll
      for (int e = 0; e < 4; ++e) { ss = fmaf(k1[gg][e], k1[gg][e], ss); ss = fmaf(k2[gg][e], k2[gg][e], ss); }
    }
#pragma unroll
    for (int nb = 0; nb < 2; ++nb)
#pragma unroll
      for (int i = 0; i < 16; ++i) ss = fmaf(acc[nb][i], acc[nb][i], ss);
    ss += xor32(ss);
    const float r = rsqrtf(ss * (1.f / 96.f) + EPS);
    bf16_t* dst = KB + ((size_t)(b * 8 + nt) * S + s) * 96;
#pragma unroll
    for (int nb = 0; nb < 2; ++nb)
#pragma unroll
      for (int pq = 0; pq < 2; ++pq) {
        const int c = 32 * nb + 8 * (2 * pq + h);
        float v[8];
        swap8(acc[nb], pq, v);
        st8(dst + c, v, r, b_kg + c);
      }
    const float posf = (float)pos[m];
#pragma unroll
    for (int gg = 0; gg < 2; ++gg) {
      const int ri0 = 8 * gg + 4 * h;
      const f32x4 g1 = *(const f32x4*)(b_kg + 64 + ri0), g2 = *(const f32x4*)(b_kg + 80 + ri0);
      float y1[4], y2[4], o1[4], o2[4];
#pragma unroll
      for (int e = 0; e < 4; ++e) { y1[e] = k1[gg][e] * r * g1[e]; y2[e] = k2[gg][e] * r * g2[e]; }
      rope4(y1, y2, gg, h, posf, o1, o2);
      st4(dst + 64 + ri0, o1[0], o1[1], o1[2], o1[3]);
      st4(dst + 80 + ri0, o2[0], o2[1], o2[2], o2[3]);
    }
    bf16_t* vd = VB + ((size_t)(b * 8 + nt) * S + s) * 64;
#pragma unroll
    for (int nb = 2; nb < 4; ++nb)
#pragma unroll
      for (int pq = 0; pq < 2; ++pq) {
        float v[8];
        swap8(acc[nb], pq, v);
        st8(vd + 32 * (nb - 2) + 8 * (2 * pq + h), v, 1.f, nullptr);
      }
  }
};

struct EpiOddIn {
  bf16_t* hb; const float *d_qg, *d_kg; unsigned char* lds;
  DI void operator()(f32x16 (&acc)[4], int m, int nt, int h, float rs) const {
    const int b = m >> 13, s = m & (S - 1);
    unsigned char* sreg = lds + EPI_LDS + (opaque_tid() >> 6) * 4096;
    const int region = nt >> 2, r4 = nt & 3;
    if (region < 5) {
#pragma unroll
      for (int hh = 0; hh < 2; ++hh) {
        float r = rs;
        const float* gain = nullptr;
        bf16_t* dst;
        if (region < 3) {
          if (region == 0) r *= QS_64;
          dst = hb + (size_t)region * (TE * 512) + ((size_t)(b * 8 + 2 * r4 + hh) * S + s) * 64;
        } else {
          float ss = 0.f;
#pragma unroll
          for (int x = 0; x < 2; ++x)
#pragma unroll
            for (int i = 0; i < 16; ++i) { const float v = acc[2 * hh + x][i] * rs; ss = fmaf(v, v, ss); }
          ss += xor32(ss);
          r = rsqrtf(ss * (1.f / 64.f) + EPS) * rs;
          if (region == 3) { gain = d_qg + hh * 64; r *= QS_64; } else gain = d_kg + hh * 64;
          dst = hb + (size_t)region * (TE * 512) + ((size_t)((b * 4 + r4) * 2 + hh) * S + s) * 64;
        }
#pragma unroll
        for (int x = 0; x < 2; ++x)
#pragma unroll
          for (int pq = 0; pq < 2; ++pq) {
            const int d = 32 * x + 8 * (2 * pq + h);
            float v[8];
            swap8(acc[2 * hh + x], pq, v);
            stage_put(sreg, m & 31, 4 * x + 2 * pq + h, pk8(v, r, gain ? gain + d : nullptr));
          }
        stage_flush(sreg, dst - (m & 31) * 64, 64);
      }
    } else {
      bf16_t* dst = hb + O_VD + ((size_t)(b * 4 + r4) * S + s) * 128;
#pragma unroll
      for (int nb = 0; nb < 4; ++nb) {
#pragma unroll
        for (int pq = 0; pq < 2; ++pq) {
          float v[8];
          swap8(acc[nb], pq, v);
          stage_put(sreg, m & 31, 4 * (nb & 1) + 2 * pq + h, pk8(v, rs, nullptr));
        }
        if (nb & 1) stage_flush(sreg, dst - (size_t)(m & 31) * 128 + 64 * (nb >> 1), 128);
      }
    }
  }
};

template <int DQK, int DV>
struct AL {
  static constexpr int KSTR = DQK * 2 + 16, VSTR = DV * 2 + 64, KBYTES = 64 * KSTR, VBYTES = 64 * VSTR, STAGE = KBYTES + VBYTES;
  static constexpr int KCH = DQK / 8, VCH = DV / 8;
  static constexpr int NKC = 8 * DQK, NVC = 8 * DV;
  static constexpr int NKR = (NKC + NT - 1) / NT, NVR = (NVC + NT - 1) / NT;
};

template <int DQK, int DV>
DI void a_gload(const bf16_t* Kt, const bf16_t* Vt, u32x4 (&rk)[AL<DQK, DV>::NKR], u32x4 (&rv)[AL<DQK, DV>::NVR], int tid) {
  typedef AL<DQK, DV> L;
#pragma unroll
  for (int q = 0; q < L::NKR; ++q) {
    const int c = tid + NT * q;
    if (c < L::NKC) rk[q] = *(const u32x4*)(Kt + (size_t)c * 8);
  }
#pragma unroll
  for (int q = 0; q < L::NVR; ++q) {
    const int c = tid + NT * q;
    if (c < L::NVC) rv[q] = *(const u32x4*)(Vt + (size_t)c * 8);
  }
}
template <int DQK, int DV>
DI void a_swrite(unsigned char* kl, unsigned char* vl, const u32x4 (&rk)[AL<DQK, DV>::NKR], const u32x4 (&rv)[AL<DQK, DV>::NVR], int tid) {
  typedef AL<DQK, DV> L;
#pragma unroll
  for (int q = 0; q < L::NKR; ++q) {
    const int c = tid + NT * q, row = c / L::KCH, cc = c - row * L::KCH;
    if (c < L::NKC) *(u32x4*)(kl + row * L::KSTR + cc * 16) = rk[q];
  }
#pragma unroll
  for (int q = 0; q < L::NVR; ++q) {
    const int c = tid + NT * q, row = c / L::VCH, cc = c - row * L::VCH;
    if (c < L::NVC) *(u32x4*)(vl + row * L::VSTR + cc * 16) = rv[q];
  }
}

template <int DV, int VSTR>
DI void v_load(const unsigned char* vl, int kb, int lane, bf16x8 (&vf)[2][DV / 32]) {
  const int h = lane >> 5, blk = (lane >> 4) & 1, q = (lane & 15) >> 2, pp = lane & 3;
  const unsigned char* a0 = vl + (32 * kb + 4 * h + q) * VSTR + (16 * blk + 4 * pp) * 2;
#pragma unroll
  for (int s2 = 0; s2 < 2; ++s2)
#pragma unroll
    for (int db = 0; db < DV / 32; ++db) {
      const unsigned char* a = a0 + 16 * s2 * VSTR + 64 * db;
      const s16x4 lo = __builtin_amdgcn_ds_read_tr16_b64_v4i16((LDS_AS s16x4*)(a));
      const s16x4 hi = __builtin_amdgcn_ds_read_tr16_b64_v4i16((LDS_AS s16x4*)(a + 8 * VSTR));
      vf[s2][db] = __builtin_shufflevector(lo, hi, 0, 1, 2, 3, 4, 5, 6, 7);
    }
}
template <int DV>
DI void pv_mma(const f32x16& p, const bf16x8 (&vf)[2][DV / 32], f32x16 (&O)[DV / 32]) {
#pragma unroll
  for (int s2 = 0; s2 < 2; ++s2) {
    const bf16x8 pf = pack8(p, 8 * s2);
#pragma unroll
    for (int db = 0; db < DV / 32; ++db) O[db] = MFMA(vf[s2][db], pf, O[db]);
  }
}

template <int MODE>
DI void attn_unit(const bf16_t* Qs, const bf16_t* Ks, const bf16_t* Vs, const bf16_t* Qs2, const bf16_t* Ks2, int qi, float slope2, float m0init,
                  float lam, float outscale, const float* subln, bf16_t* mixdst, float* stash, unsigned char* lds, float bnd0 = 0.f, float bnd1 = 0.f) {
  constexpr int DQK = (MODE == 1) ? 96 : 64, DV = (MODE == 3) ? 128 : 64, NDB = DV / 32, NKS = DQK / 16;
  typedef AL<DQK, DV> L;
  const int tid = opaque_tid(), lane = tid & 63, w = tid >> 6, h = lane >> 5, r = lane & 31;
  const int q0 = qi * 256;
  const int qrow = q0 + 32 * w + r;
  const int cw = (q0 + 32 * w) >> 6;
  const int gbw = (q0 + 32 * w) >> 5;
  const int jhi = 4 * qi + 3;
  int jlo = 0;
  if (MODE == 0) jlo = (4 * qi - 2) > 0 ? (4 * qi - 2) : 0;
  const int ntl = jhi - jlo + 1;
  constexpr int NPASS = (MODE == 3) ? 2 : 1;
#pragma unroll
  for (int pass = 0; pass < NPASS; ++pass) {
    const bf16_t* Qp = pass ? Qs2 : Qs;
    const bf16_t* Kp = pass ? Ks2 : Ks;
    bf16x8 qf[NKS];
#pragma unroll
    for (int s = 0; s < NKS; ++s) qf[s] = *(const bf16x8*)(Qp + (size_t)qrow * DQK + 16 * s + 8 * h);
    f32x16 O[NDB];
#pragma unroll
    for (int db = 0; db < NDB; ++db) O[db] = zero16();
    float m = (MODE == 0) ? m0init : -1e30f;
    float l = (MODE == 0 && h == 0) ? 1.f : 0.f;
    float c = 0.f;
    u32x4 rk[L::NKR], rv[L::NVR];
    {
      const int j0 = (MODE >= 2) ? jhi : jlo;
      a_gload<DQK, DV>(Kp + (size_t)j0 * 64 * DQK, Vs + (size_t)j0 * 64 * DV, rk, rv, tid);
      a_swrite<DQK, DV>(lds, lds + L::KBYTES, rk, rv, tid);
    }
    __builtin_amdgcn_s_waitcnt(0x0F70);
    __syncthreads();
    for (int it = 0; it < ntl; ++it) {
      const int j = (MODE >= 2) ? jhi - it : jlo + it;
      const bool more = it + 1 < ntl;
      if (more) {
        const int jn = (MODE >= 2) ? j - 1 : j + 1;
        a_gload<DQK, DV>(Kp + (size_t)jn * 64 * DQK, Vs + (size_t)jn * 64 * DV, rk, rv, tid);
      }
      const unsigned char* kl = lds + (it & 1) * L::STAGE;
      const unsigned char* vl = kl + L::KBYTES;
      if (MODE != 2) {
        const bool ok = (j <= cw) && (MODE != 0 || j >= cw - 2);
        if (ok && DV == 64) {
          f32x16 sc0 = zero16(), sc1 = zero16();
          bf16x8 vfa[2][NDB], vfb[2][NDB];
          {
            const unsigned char* kp = kl + r * L::KSTR + 16 * h;
            bf16x8 kf[NKS], kg[NKS];
#pragma unroll
            for (int s = 0; s < NKS; ++s) kf[s] = *(const bf16x8*)(kp + 32 * s);
            __builtin_amdgcn_sched_barrier(0);
#pragma unroll
            for (int s = 0; s < NKS; ++s) kg[s] = *(const bf16x8*)(kp + 32 * L::KSTR + 32 * s);
            __builtin_amdgcn_sched_barrier(0);
#pragma unroll
            for (int s = 0; s < NKS; ++s) sc0 = MFMA(kf[s], qf[s], sc0);
            __builtin_amdgcn_sched_barrier(0);
            v_load<DV, L::VSTR>(vl, 0, lane, vfa);
            v_load<DV, L::VSTR>(vl, 1, lane, vfb);
            __builtin_amdgcn_sched_barrier(0);
#pragma unroll
            for (int s = 0; s < NKS; ++s) sc1 = MFMA(kg[s], qf[s], sc1);
            __builtin_amdgcn_sched_barrier(0);
          }
          if (MODE == 0) {
            const float fl = (float)(qrow - (64 * j + 4 * h));
#pragma unroll
            for (int i = 0; i < 16; ++i) {
              sc0[i] = fmaf(-slope2, fabsf(fl - (float)((i & 3) + 8 * (i >> 2))), sc0[i]);
              sc1[i] = fmaf(-slope2, fabsf(fl - (float)(32 + (i & 3) + 8 * (i >> 2))), sc1[i]);
            }
          }
          float mx = fmaxf(sc0[0], sc1[0]);
#pragma unroll
          for (int i = 1; i < 16; ++i) mx = fmaxf(mx, fmaxf(sc0[i], sc1[i]));
          mx = fmaxf(mx, xor32(mx));
          const float mn = fmaxf(m, mx);
          if (__any(mn > m)) {
            const float alpha = ex2(m - mn);
            l *= alpha;
#pragma unroll
            for (int db = 0; db < NDB; ++db) O[db] = O[db] * alpha;
          }
          m = mn;
          float ps = 0.f;
#pragma unroll
          for (int i = 0; i < 16; ++i) { const float pe = ex2(sc0[i] - mn); sc0[i] = pe; ps += pe; }
          pv_mma<DV>(sc0, vfa, O);
#pragma unroll
          for (int i = 0; i < 16; ++i) { const float pe = ex2(sc1[i] - mn); sc1[i] = pe; ps += pe; }
          l += ps;
          pv_mma<DV>(sc1, vfb, O);
        } else if (ok) {
#pragma unroll 1
          for (int kb = 0; kb < 2; ++kb) {
            const unsigned char* kp = kl + (32 * kb + r) * L::KSTR + 16 * h;
            bf16x8 kf[NKS];
#pragma unroll
            for (int s = 0; s < NKS; ++s) kf[s] = *(const bf16x8*)(kp + 32 * s);
            bf16x8 vf[2][NDB];
            v_load<DV, L::VSTR>(vl, kb, lane, vf);
            __builtin_amdgcn_sched_barrier(0);
            const float fl = (float)(qrow - (64 * j + 32 * kb + 4 * h));
            const bool far = (MODE == 0 || MODE == 3) && (64 * j + 32 * kb + 31 < q0 + 32 * w);
            const float sl_i = far ? slope2 : 0.f;
            f32x16 sc;
#pragma unroll
            for (int i = 0; i < 16; ++i) sc[i] = sl_i * (float)((i & 3) + 8 * (i >> 2));
#pragma unroll
            for (int s = 0; s < NKS; ++s) sc = MFMA(kf[s], qf[s], sc);
            if ((MODE == 0 || MODE == 3) && !far) {
#pragma unroll
              for (int i = 0; i < 16; ++i) sc[i] = fmaf(-slope2, fabsf(fl - (float)((i & 3) + 8 * (i >> 2))), sc[i]);
            }
            const float u = far ? -slope2 * fl : 0.f;
            float mx = sc[0];
#pragma unroll
            for (int i = 1; i < 16; ++i) mx = fmaxf(mx, sc[i]);
            mx += u;
            mx = fmaxf(mx, xor32(mx));
            const float mn = fmaxf(m, mx);
            if (__any(mn > m)) {
              const float alpha = ex2(m - mn);
              l *= alpha;
#pragma unroll
              for (int db = 0; db < NDB; ++db) O[db] = O[db] * alpha;
            }
            m = mn;
            const float shift = mn - u;
            float ps = 0.f;
#pragma unroll
            for (int i = 0; i < 16; ++i) { const float pe = ex2(sc[i] - shift); sc[i] = pe; ps += pe; }
            l += ps;
            pv_mma<DV>(sc, vf, O);
          }
        }
      } else {
#pragma unroll 1
        for (int kk = 0; kk < 2; ++kk) {
          const int kb = 1 - kk;
          const int gb = 2 * j + kb;
          if (gb <= gbw) {
            const bool diag = gb == gbw;
            const unsigned char* kp = kl + (32 * kb + r) * L::KSTR + 16 * h;
            bf16x8 kf[NKS];
#pragma unroll
            for (int s = 0; s < NKS; ++s) kf[s] = *(const bf16x8*)(kp + 32 * s);
            bf16x8 vf[2][NDB];
            v_load<DV, L::VSTR>(vl, kb, lane, vf);
            __builtin_amdgcn_sched_barrier(0);
            f32x16 z = zero16();
#pragma unroll
            for (int s = 0; s < NKS; ++s) z = MFMA(kf[s], qf[s], z);
            f32x16 sp;
#pragma unroll
            for (int i = 0; i < 16; ++i) {
              const float zi = z[i];
              const float e = ex2(-fabsf(zi));
              float v = fmaxf(zi, 0.f) + lg2(1.f + e);
              const int key = (i & 3) + 8 * (i >> 2) + 4 * h;
              if (diag && key >= r) v = 0.f;
              sp[i] = v;
            }
            float Tg[4], Tp[4], offs[4];
#pragma unroll
            for (int g = 0; g < 4; ++g) { Tg[g] = (sp[4 * g] + sp[4 * g + 1]) + (sp[4 * g + 2] + sp[4 * g + 3]); Tp[g] = xor32(Tg[g]); }
            float run = 0.f;
#pragma unroll
            for (int g = 3; g >= 0; --g) { offs[g] = run + (h == 0 ? Tp[g] : 0.f); run += Tg[g] + Tp[g]; }
#pragma unroll
            for (int g = 3; g >= 0; --g) {
              float a = c + offs[g];
#pragma unroll
              for (int e = 3; e >= 0; --e) {
                const int i = 4 * g + e;
                a += sp[i];
                float pe = ex2(z[i] - a);
                const int key = (i & 3) + 8 * (i >> 2) + 4 * h;
                if (diag && key >= r) pe = 0.f;
                z[i] = pe;
              }
            }
            c += run;
            pv_mma<DV>(z, vf, O);
          }
        }
      }
      if (more) {
        unsigned char* kn = lds + ((it + 1) & 1) * L::STAGE;
        a_swrite<DQK, DV>(kn, kn + L::KBYTES, rk, rv, tid);
      }
      if (MODE == 3) {
        volatile int* fl = (volatile int*)(lds + LDS_TILE_BYTES) + (it & 1) * 8;
        const float dmin = (float)((q0 + 32 * w) - (64 * j - 1));
        const float bnd = pass ? bnd1 : bnd0;
        const int done = __all(bnd - slope2 * dmin < m - 150.f) ? 1 : 0;
        if (lane == 0) fl[w] = done;
        __syncthreads();
        if (fl[0] + fl[1] + fl[2] + fl[3] + fl[4] + fl[5] + fl[6] + fl[7] == 8) break;
      } else if (MODE == 2) {
        volatile int* fl = (volatile int*)(lds + LDS_TILE_BYTES) + (it & 1) * 8;
        const int done = __all(c > 160.f) ? 1 : 0;
        if (lane == 0) fl[w] = done;
        __syncthreads();
        if (fl[0] + fl[1] + fl[2] + fl[3] + fl[4] + fl[5] + fl[6] + fl[7] == 8) break;
      } else
        __syncthreads();
    }
    bf16_t* orow = mixdst + (size_t)(32 * w + r) * DM;
    if (MODE == 2) {
#pragma unroll
      for (int db = 0; db < NDB; ++db)
#pragma unroll
        for (int pq = 0; pq < 2; ++pq) {
          float v[8];
          swap8(O[db], pq, v);
          st8(orow + 32 * db + 8 * (2 * pq + h), v, 1.f, nullptr);
        }
    } else {
      const float lt = l + xor32(l);
      const float inv = 1.f / lt;
      if (MODE != 3) {
#pragma unroll
        for (int db = 0; db < NDB; ++db)
#pragma unroll
          for (int pq = 0; pq < 2; ++pq) {
            float v[8];
            swap8(O[db], pq, v);
            st8(orow + 32 * db + 8 * (2 * pq + h), v, inv, nullptr);
          }
      } else if (pass == 0) {
#pragma unroll
        for (int db = 0; db < NDB; ++db)
#pragma unroll
          for (int g = 0; g < 4; ++g) {
            f32x4 v = {O[db][4 * g] * inv, O[db][4 * g + 1] * inv, O[db][4 * g + 2] * inv, O[db][4 * g + 3] * inv};
            *(f32x4*)(stash + tid * 64 + db * 16 + 4 * g) = v;
          }
      } else {
        const float li = lam * inv;
        float ss = 0.f;
#pragma unroll
        for (int db = 0; db < NDB; ++db)
#pragma unroll
          for (int g = 0; g < 4; ++g) {
            const f32x4 o1 = *(const f32x4*)(stash + tid * 64 + db * 16 + 4 * g);
#pragma unroll
            for (int e = 0; e < 4; ++e) { const float v = o1[e] - li * O[db][4 * g + e]; O[db][4 * g + e] = v; ss = fmaf(v, v, ss); }
          }
        ss += xor32(ss);
        const float rr = rsqrtf(ss * (1.f / 128.f) + EPS) * outscale;
#pragma unroll
        for (int db = 0; db < NDB; ++db)
#pragma unroll
          for (int pq = 0; pq < 2; ++pq) {
            const int d = 32 * db + 8 * (2 * pq + h);
            float v[8];
            swap8(O[db], pq, v);
            st8(orow + d, v, rr, subln + d);
          }
      }
    }
  }
}

DI int next_unit(int* ctr, unsigned char* lds) {
  volatile int* slot = (volatile int*)(lds + LDS_TILE_BYTES + 64);
  if (threadIdx.x == 0) *slot = atomicAdd(ctr, 1);
  __syncthreads();
  const int u = *slot;
  __syncthreads();
  return u;
}

DI void attn_even(const Params& p, int j, int* ctr, unsigned char* lds) {
  bf16_t* hb = (bf16_t*)(p.ws + WS_HID);
  bf16_t* mix = (bf16_t*)(p.ws + WS_MIX);
  for (;;) {
    int u = next_unit(ctr, lds);
    if (u >= 2048) break;
    if (u < 1024) {
      const int qi = 31 - (u >> 5), b = (u >> 3) & 3, hd = u & 7;
      const size_t sl = (size_t)(b * 8 + hd) * S;
      attn_unit<1>(hb + E_QB + sl * 96, hb + E_KB + sl * 96, hb + E_VB + sl * 64, nullptr, nullptr, qi, 0.f, 0.f, 0.f, 0.f, nullptr,
                   mix + ((size_t)b * S + qi * 256) * DM + 512 + hd * 64, nullptr, lds);
    } else {
      u -= 1024;
      const int qi = 31 - (u >> 5), b = (u >> 3) & 3, hd = u & 7, g = hd >> 2;
      const size_t sl = (size_t)(b * 8 + hd) * S, slk = (size_t)(b * 2 + g) * S;
      const float slope2 = exp2f(-(float)(hd + 1)) * LOG2E;
      const float m0 = p.in[10][j * 8 + hd] * LOG2E;
      attn_unit<0>(hb + E_QA + sl * 64, hb + E_KA + slk * 64, hb + E_VA + slk * 64, nullptr, nullptr, qi, slope2, m0, 0.f, 0.f, nullptr,
                   mix + ((size_t)b * S + qi * 256) * DM + hd * 64, nullptr, lds);
    }
  }
}

DI void attn_odd(const Params& p, int j, int* ctr, unsigned char* lds) {
  bf16_t* hb = (bf16_t*)(p.ws + WS_HID);
  bf16_t* mix = (bf16_t*)(p.ws + WS_MIX);
  const float* lf = p.in[21] + j * 256;
  float d01 = 0.f, d23 = 0.f;
  for (int i = 0; i < 64; ++i) { d01 = fmaf(lf[i], lf[64 + i], d01); d23 = fmaf(lf[128 + i], lf[192 + i], d23); }
  const float lambda_init = 0.8f - 0.6f * expf(-0.3f * (float)(2 * j + 1));
  const float lam = expf(d01) - expf(d23) + lambda_init;
  float bnd[2];
  for (int wh = 0; wh < 2; ++wh) {
    float gq = 0.f, gk = 0.f;
    for (int i = 0; i < 64; ++i) { gq = fmaxf(gq, fabsf(p.in[19][j * 128 + wh * 64 + i])); gk = fmaxf(gk, fabsf(p.in[20][j * 128 + wh * 64 + i])); }
    bnd[wh] = 8.f * LOG2E * 1.01f * gq * gk;
  }
  for (;;) {
    int u = next_unit(ctr, lds);
    if (u >= 1536) break;
    if (u < 512) {
      const int qi = 31 - (u >> 4), b = (u >> 2) & 3, hd = u & 3;
      const size_t sl0 = (size_t)((b * 4 + hd) * 2) * S, slv = (size_t)(b * 4 + hd) * S;
      const float slope2 = exp2f(-2.f * (float)(hd + 1)) * LOG2E;
      attn_unit<3>(hb + O_QD + sl0 * 64, hb + O_KD + sl0 * 64, hb + O_VD + slv * 128, hb + O_QD + (sl0 + S) * 64, hb + O_KD + (sl0 + S) * 64, qi, slope2,
                   0.f, lam, 1.f - lambda_init, p.in[22] + j * 128, mix + ((size_t)b * S + qi * 256) * DM + 512 + hd * 128,
                   (float*)(p.ws + WS_STASH) + (size_t)blockIdx.x * 32768, lds, bnd[0], bnd[1]);
    } else {
      u -= 512;
      const int qi = 31 - (u >> 5), b = (u >> 3) & 3, hd = u & 7;
      const size_t sl = (size_t)(b * 8 + hd) * S;
      attn_unit<2>(hb + O_QC + sl * 64, hb + O_KC + sl * 64, hb + O_VC + sl * 64, nullptr, nullptr, qi, 0.f, 0.f, 0.f, 0.f, nullptr,
                   mix + ((size_t)b * S + qi * 256) * DM + hd * 64, nullptr, lds);
    }
  }
}

#define XB_TMO      128
#define XB_XCNT(j)  (256  + 64 * (j))
#define XB_XSUB(j)  (1280 + 64 * (j))
#define XB_XGEN(j)  (2304 + 64 * (j))
#define XB_TOP      3328
#define XB_TOPGEN   3392
#define XCD_BAR_WORDS 3456
#define XB_SPIN_CAP (1u << 22)
DI unsigned xb_ld(unsigned* p) { return __hip_atomic_load(p, __ATOMIC_RELAXED, __HIP_MEMORY_SCOPE_AGENT); }
DI unsigned xb_add(unsigned* p, unsigned v) { return __hip_atomic_fetch_add(p, v, __ATOMIC_RELAXED, __HIP_MEMORY_SCOPE_AGENT); }
DI unsigned xb_xcc_id() { return (unsigned)__builtin_amdgcn_s_getreg((3 << 11) | 20) & 0xFu; }
#define XB_SPIN(cond, bar) do { unsigned _sp = 0; while (cond) { __builtin_amdgcn_s_sleep(1); \
    if ((++_sp & 255u) == 0u) { if (xb_ld(&(bar)[XB_TMO])) break; if (_sp > XB_SPIN_CAP) { atomicAdd(&(bar)[XB_TMO], 1u); break; } } } } while (0)
struct XcdBarrier { unsigned* bar; unsigned x; volatile LDS_AS unsigned* st; };
DI XcdBarrier xcd_barrier_post(unsigned* bar, volatile LDS_AS unsigned* st) {
  XcdBarrier b; b.bar = bar; b.x = xb_xcc_id(); b.st = st;
  if (threadIdx.x == 0) (void)xb_add(&bar[XB_XCNT(b.x)], 1u);
  return b;
}
DI void xcd_barrier_complete(unsigned* bar, unsigned x, unsigned& nloc, unsigned& nx) {
  const unsigned G = gridDim.x * gridDim.y * gridDim.z;
  unsigned sum, cnt, mine, sp = 0u;
  for (;;) {
    sum = 0u; cnt = 0u; mine = 0u;
#pragma unroll
    for (unsigned j = 0; j < 16; ++j) { const unsigned c = xb_ld(&bar[XB_XCNT(j)]); sum += c; cnt += (c > 0u) ? 1u : 0u; mine = (j == x) ? c : mine; }
    if (sum == G) break;
    __builtin_amdgcn_s_sleep(1);
    if ((++sp & 255u) == 0u) { if (xb_ld(&bar[XB_TMO])) break; if (sp > XB_SPIN_CAP) { atomicAdd(&bar[XB_TMO], 1u); break; } }
  }
  nloc = mine > 0u ? mine : 1u; nx = cnt > 0u ? cnt : 1u;
}
DI void xcd_barrier(const XcdBarrier& b) {
  asm volatile("s_waitcnt vmcnt(0)" ::: "memory");
  __syncthreads();
  if (threadIdx.x == 0) {
    unsigned* bar = b.bar;
    __builtin_amdgcn_s_waitcnt(0);
    unsigned nloc = b.st[0], nx = b.st[1];
    if (nloc == 0u) { xcd_barrier_complete(bar, b.x, nloc, nx); b.st[0] = nloc; b.st[1] = nx; }
    const unsigned old = xb_add(&bar[XB_XSUB(b.x)], 1u);
    const unsigned gen = old / nloc;
    if (old + 1u == (gen + 1u) * nloc) {
      __builtin_amdgcn_fence(__ATOMIC_RELEASE, "agent");
      asm volatile("s_waitcnt vmcnt(0)" ::: "memory");
      const unsigned og = xb_add(&bar[XB_TOP], 1u);
      const unsigned tg = og / nx;
      if (og + 1u == (tg + 1u) * nx) xb_add(&bar[XB_TOPGEN], 1u);
      else XB_SPIN(xb_ld(&bar[XB_TOPGEN]) == tg, bar);
      __builtin_amdgcn_fence(__ATOMIC_ACQUIRE, "agent");
      xb_add(&bar[XB_XGEN(b.x)], 1u);
      asm volatile("s_waitcnt vmcnt(0)" ::: "memory");
    } else {
      XB_SPIN(xb_ld(&bar[XB_XGEN(b.x)]) == gen, bar);
      __builtin_amdgcn_fence(__ATOMIC_ACQUIRE, "agent");
      asm volatile("s_waitcnt vmcnt(0)" ::: "memory");
    }
  }
  __syncthreads();
}

enum { K_PRO = 0, K_IN_E, K_UP_E, K_ATT_E, K_IN_O, K_ATT_O, K_OUT, K_MLPUP, K_DOWN };

extern "C" __global__ void __launch_bounds__(512) fwd_kernel(Params p, int ph_lo, int ph_hi) {
  extern __shared__ __attribute__((aligned(16))) unsigned char lds[];
  cg::grid_group grid = cg::this_grid();
  volatile LDS_AS unsigned* xst = (volatile LDS_AS unsigned*)(lds + LDS_TILE_BYTES + 96);
  if (threadIdx.x == 0) { xst[0] = 0u; xst[1] = 0u; }
  __syncthreads();
  XcdBarrier gbar = xcd_barrier_post((unsigned*)(p.ws + WS_BAR), xst);
  unsigned char* wb = p.ws + WS_W;
  bf16_t* xb = (bf16_t*)(p.ws + WS_XB);
  bf16_t* mix = (bf16_t*)(p.ws + WS_MIX);
  bf16_t* hb = (bf16_t*)(p.ws + WS_HID);
  int* ctr = (int*)(p.ws + WS_CTR);
  const int* pos = (const int*)p.in[1];
  for (int ph = ph_lo; ph < ph_hi; ++ph) {
    int kind = K_PRO, L = 0;
    if (ph > 0) {
      const int q = ph - 1, pair = q / 11, rr = q - pair * 11;
      if (rr < 6) { L = 2 * pair; kind = rr == 0 ? K_IN_E : rr == 1 ? K_UP_E : rr == 2 ? K_ATT_E : rr == 3 ? K_OUT : rr == 4 ? K_MLPUP : K_DOWN; }
      else { L = 2 * pair + 1; kind = rr == 6 ? K_IN_O : rr == 7 ? K_ATT_O : rr == 8 ? K_OUT : rr == 9 ? K_MLPUP : K_DOWN; }
    }
    const int j = L >> 1;
    for (int rep = 0; rep < ((kind == PROBE_KIND) ? 2 : 1); ++rep) {
    if (kind == K_PRO) {
      prologue(p, lds);
    } else if (kind == K_IN_E) {
      EpiEvenIn e{hb, p.in[8] + j * 64, p.in[9] + j * 64, p.in[12] + j * 128, lds};
      gemm_phase<true>(xb, 1024, (const bf16_t*)(wb + W_IN_E) + (size_t)j * 1280 * 1024, 1024, 5, e, lds);
    } else if (kind == K_UP_E) {
      EpiUQ e1{hb + E_QB, p.in[15] + j * 96, pos};
      gemm_phase<true>(hb + E_CQ, 256, (const bf16_t*)(wb + W_UQ) + (size_t)j * 1024 * 256, 256, 4, e1, lds);
      EpiUKV e2{hb + E_KB, hb + E_VB, (const float*)(hb + E_KR), p.in[16] + j * 96, pos};
      gemm_phase<false>(hb + E_CKV, 128, (const bf16_t*)(wb + W_UKV) + (size_t)j * 1024 * 128, 128, 4, e2, lds);
    } else if (kind == K_ATT_E) {
      attn_even(p, j, ctr + L + 4 * rep, lds);
    } else if (kind == K_IN_O) {
      EpiOddIn e{hb, p.in[19] + j * 128, p.in[20] + j * 128, lds};
      gemm_phase<true>(xb, 1024, (const bf16_t*)(wb + W_IN_O) + (size_t)j * 3072 * 1024, 1024, 12, e, lds);
    } else if (kind == K_ATT_O) {
      attn_odd(p, j, ctr + L + 4 * rep, lds);
    } else if (kind == K_OUT || kind == K_DOWN) {
      const bool isout = kind == K_OUT;
      EpiResid e{(isout && L == 0) ? p.in[0] : nullptr, xb, (!isout && L == 3) ? p.out : nullptr, lds};
      const bf16_t* Bt = isout ? ((L & 1) ? (const bf16_t*)(wb + W_OUT_O) : (const bf16_t*)(wb + W_OUT_E)) + (size_t)j * 1024 * 1024
                               : (const bf16_t*)(wb + W_DN) + (size_t)L * 1024 * 4096;
      gemm_phase<false>(isout ? mix : hb, isout ? 1024 : 4096, Bt, isout ? 1024 : 4096, 4, e, lds);
    } else {
      EpiRelu2 e{hb, lds};
      gemm_phase<true>(xb, 1024, (const bf16_t*)(wb + W_UP) + (size_t)L * 4096 * 1024, 1024, 16, e, lds);
    }
    if (PROBE_KIND >= 0) __syncthreads();
    }
    if (ph + 1 < ph_hi) {
      if (ph == ph_lo) grid.sync();
      else xcd_barrier(gbar);
    }
  }
}

extern "C" void kernel_launch(void* const* d_in, const int* in_sizes, int n_in, void* d_out, int out_size, void* d_ws, size_t ws_size,
                              hipStream_t stream) {
  static int grid_blocks = 0;
  if (grid_blocks == 0) {
    if (n_in != 23 || out_size != T * DM || ws_size < WS_END) {
      fprintf(stderr, "kernel_launch: unexpected shapes (n_in %d out %d ws %zu need %zu)\n", n_in, out_size, ws_size, (size_t)WS_END);
      grid_blocks = -1;
      return;
    }
    int dev = 0, cus = 0, per_cu = 0;
    hipGetDevice(&dev);
    hipDeviceGetAttribute(&cus, hipDeviceAttributeMultiprocessorCount, dev);
    if (hipFuncSetAttribute((const void*)fwd_kernel, hipFuncAttributeMaxDynamicSharedMemorySize, LDS_BYTES) != hipSuccess)
      fprintf(stderr, "kernel_launch: hipFuncSetAttribute failed\n");
    hipOccupancyMaxActiveBlocksPerMultiprocessor(&per_cu, (const void*)fwd_kernel, NT, LDS_BYTES);
    if (per_cu > 1) per_cu = 1;
    if (per_cu < 1) { fprintf(stderr, "kernel_launch: occupancy query gave %d\n", per_cu); per_cu = 1; }
    grid_blocks = cus * per_cu;
  }
  if (grid_blocks < 0) return;
  Params p{};
  for (int i = 0; i < 23; ++i) p.in[i] = (const float*)d_in[i];
  p.out = (float*)d_out;
  p.ws = (unsigned char*)d_ws;
  if (hipMemsetAsync((char*)d_ws + WS_BAR, 0, 16384, stream) != hipSuccess) fprintf(stderr, "kernel_launch: memset of barrier words failed\n");
#if MULTI_LAUNCH
  for (int ph = 0; ph < NPHASE; ++ph) hipLaunchKernelGGL(fwd_kernel, dim3(grid_blocks), dim3(NT), LDS_BYTES, stream, p, ph, ph + 1);
#else
  int lo = 0, hi = NPHASE;
  void* args[] = {&p, &lo, &hi};
  hipError_t e = hipLaunchCooperativeKernel((const void*)fwd_kernel, dim3(grid_blocks), dim3(NT), args, LDS_BYTES, stream);
  if (e != hipSuccess) fprintf(stderr, "cooperative launch failed: %s (grid %d)\n", hipGetErrorString(e), grid_blocks);
#endif
}
```

```cpp
#include <hip/hip_runtime.h>
#include <hip/hip_cooperative_groups.h>
#include <cstdio>
#include <cstdint>
namespace cg = cooperative_groups;

#ifndef PROBE_KIND
#define PROBE_KIND -1
#endif
#ifndef MULTI_LAUNCH
#define MULTI_LAUNCH 0
#endif

typedef unsigned short bf16_t;
typedef short bf16x8 __attribute__((ext_vector_type(8)));
typedef short s16x4 __attribute__((ext_vector_type(4)));
typedef float f32x16 __attribute__((ext_vector_type(16)));
typedef float f32x4 __attribute__((ext_vector_type(4)));
typedef float f32x2 __attribute__((ext_vector_type(2)));
typedef __bf16 bf16x2_t __attribute__((ext_vector_type(2)));
typedef unsigned u32x2 __attribute__((ext_vector_type(2)));
typedef unsigned u32x4 __attribute__((ext_vector_type(4)));
#define DI __device__ __forceinline__
#define LDS_AS __attribute__((address_space(3)))

constexpr int T = 32768, S = 8192, DM = 1024, DFF = 4096;
constexpr float EPS = 1e-6f;
constexpr float LOG2E = 1.4426950408889634f;
constexpr int NPHASE = 23;
constexpr int NT = 512;
constexpr int LDS_TILE_BYTES = 147456;
constexpr int LDS_BYTES = LDS_TILE_BYTES + 128;

constexpr size_t MiB = 1024 * 1024;
constexpr size_t WS_XB = 0;
constexpr size_t WS_MIX = 64 * MiB;
constexpr size_t WS_HID = 128 * MiB;
constexpr size_t WS_W = 384 * MiB;
constexpr size_t W_IN_E = 0;
constexpr size_t W_UQ = W_IN_E + 2ull * 1280 * 1024 * 2;
constexpr size_t W_UKV = W_UQ + 2ull * 1024 * 256 * 2;
constexpr size_t W_OUT_E = W_UKV + 2ull * 1024 * 128 * 2;
constexpr size_t W_IN_O = W_OUT_E + 2ull * 1024 * 1024 * 2;
constexpr size_t W_OUT_O = W_IN_O + 2ull * 3072 * 1024 * 2;
constexpr size_t W_UP = W_OUT_O + 2ull * 1024 * 1024 * 2;
constexpr size_t W_DN = W_UP + 4ull * 4096 * 1024 * 2;
constexpr size_t W_END = W_DN + 4ull * 4096 * 1024 * 2;
constexpr size_t WS_CTR = WS_W + W_END;
constexpr size_t WS_BAR = WS_CTR + 256;
constexpr size_t WS_STASH = WS_BAR + 16384;
constexpr size_t WS_END = WS_STASH + 256ull * 131072;
constexpr size_t TE = (size_t)T;
constexpr size_t E_QA = 0, E_KA = E_QA + TE * 512, E_VA = E_KA + TE * 128, E_CQ = E_VA + TE * 128, E_CKV = E_CQ + TE * 256,
                 E_QB = E_CKV + TE * 128, E_KB = E_QB + TE * 768, E_VB = E_KB + TE * 768, E_KR = E_VB + TE * 512  ;
constexpr size_t O_QC = 0, O_KC = TE * 512, O_VC = TE * 1024, O_QD = TE * 1536, O_KD = TE * 2048, O_VD = TE * 2560;

struct Params {
  const float* in[23];
  float* out;
  unsigned char* ws;
};

DI unsigned pack2(float lo, float hi) {
  f32x2 f = {lo, hi};
  bf16x2_t b = __builtin_convertvector(f, bf16x2_t);
  return __builtin_bit_cast(unsigned, b);
}
DI void st4(bf16_t* p, float a, float b, float c, float d) {
  u32x2 v = {pack2(a, b), pack2(c, d)};
  *(u32x2*)p = v;
}
DI bf16x8 pack8(const f32x16& x, int o) {
  u32x4 v = {pack2(x[o], x[o + 1]), pack2(x[o + 2], x[o + 3]), pack2(x[o + 4], x[o + 5]), pack2(x[o + 6], x[o + 7])};
  return __builtin_bit_cast(bf16x8, v);
}
DI float ex2(float x) { return __builtin_amdgcn_exp2f(x); }
DI float lg2(float x) { return __builtin_amdgcn_logf(x); }
DI float xor32(float x) { return __shfl_xor(x, 32); }
#define MFMA(a, b, c) __builtin_amdgcn_mfma_f32_32x32x16_bf16((a), (b), (c), 0, 0, 0)
DI int opaque_tid() { int t = threadIdx.x; asm volatile("" : "+v"(t)); return t; }
DI f32x16 zero16() { f32x16 z; for (int i = 0; i < 16; ++i) z[i] = 0.f; return z; }

DI void tconv(const float* __restrict__ src, const float* __restrict__ gain, int N, int K, bf16_t* __restrict__ dst, int Npad, int grp,
              int grp_pad, unsigned char* lds) {
  const int tid5 = opaque_tid();
  const int half = tid5 >> 8, tid = tid5 & 255;
  float* tile = (float*)lds + half * (64 * 33);
  const int nkt = K >> 6, ntl = (Npad >> 5) * nkt;
  for (int tt = blockIdx.x; 2 * tt < ntl; tt += gridDim.x) {
    const int t = 2 * tt + half;
    const bool active = t < ntl;
    const int ntile = t / nkt, kt = t - ntile * nkt;
    const int np0 = ntile * 32, k0 = kt * 64;
    const int gi = np0 / grp_pad, go = np0 - gi * grp_pad;
    const int sn0 = gi * grp + go;
    const bool valid = active && (go < grp) && (sn0 < N);
    if (valid) {
#pragma unroll
      for (int p = 0; p < 2; ++p) {
        const int kk = (tid >> 3) + 32 * p, nn = (tid & 7) * 4;
        const f32x4 v = *(const f32x4*)(src + (size_t)(k0 + kk) * N + sn0 + nn);
        const float gsc = gain ? gain[k0 + kk] : 1.f;
#pragma unroll
        for (int e = 0; e < 4; ++e) tile[kk * 33 + nn + e] = v[e] * gsc;
      }
    }
    __syncthreads();
    if (active) {
      const int n = tid >> 3, kq = (tid & 7) * 8;
      u32x4 o = {0u, 0u, 0u, 0u};
      if (valid) {
        float f[8];
#pragma unroll
        for (int j = 0; j < 8; ++j) f[j] = tile[(kq + j) * 33 + n];
        o[0] = pack2(f[0], f[1]); o[1] = pack2(f[2], f[3]); o[2] = pack2(f[4], f[5]); o[3] = pack2(f[6], f[7]);
      }
      *(u32x4*)(dst + (size_t)(np0 + n) * K + k0 + kq) = o;
    }
    __syncthreads();
  }
}

DI void prologue(const Params& p, unsigned char* lds) {
  unsigned char* wb = p.ws + WS_W;
  if (blockIdx.x == 0 && threadIdx.x < 64) ((int*)(p.ws + WS_CTR))[threadIdx.x] = 0;
  {
    const float* x = p.in[0];
    bf16_t* xb = (bf16_t*)(p.ws + WS_XB);
    const size_t n8 = (size_t)T * DM / 8;
    for (size_t i = (size_t)blockIdx.x * NT + threadIdx.x; i < n8; i += (size_t)gridDim.x * NT) {
      const f32x4 a = *(const f32x4*)(x + i * 8), b = *(const f32x4*)(x + i * 8 + 4);
      u32x4 o = {pack2(a[0], a[1]), pack2(a[2], a[3]), pack2(b[0], b[1]), pack2(b[2], b[3])};
      *(u32x4*)(xb + i * 8) = o;
    }
  }
  for (int j = 0; j < 2; ++j) {
    tconv(p.in[6] + (size_t)j * 1024 * 1184, p.in[2] + (2 * j) * 1024, 1184, 1024, (bf16_t*)(wb + W_IN_E) + (size_t)j * 1280 * 1024, 1280, 1280, 1280, lds);
    tconv(p.in[13] + (size_t)j * 256 * 768, p.in[11] + j * 256, 768, 256, (bf16_t*)(wb + W_UQ) + (size_t)j * 1024 * 256, 1024, 96, 128, lds);
    tconv(p.in[14] + (size_t)j * 128 * 1024, nullptr, 1024, 128, (bf16_t*)(wb + W_UKV) + (size_t)j * 1024 * 128, 1024, 1024, 1024, lds);
    tconv(p.in[7] + (size_t)j * 1024 * 1024, nullptr, 1024, 1024, (bf16_t*)(wb + W_OUT_E) + (size_t)j * 1024 * 1024, 1024, 1024, 1024, lds);
    tconv(p.in[17] + (size_t)j * 1024 * 3072, p.in[2] + (2 * j + 1) * 1024, 3072, 1024, (bf16_t*)(wb + W_IN_O) + (size_t)j * 3072 * 1024, 3072, 3072, 3072, lds);
    tconv(p.in[18] + (size_t)j * 1024 * 1024, nullptr, 1024, 1024, (bf16_t*)(wb + W_OUT_O) + (size_t)j * 1024 * 1024, 1024, 1024, 1024, lds);
  }
  for (int L = 0; L < 4; ++L) {
    tconv(p.in[4] + (size_t)L * 1024 * 4096, p.in[3] + L * 1024, 4096, 1024, (bf16_t*)(wb + W_UP) + (size_t)L * 4096 * 1024, 4096, 4096, 4096, lds);
    tconv(p.in[5] + (size_t)L * 4096 * 1024, nullptr, 1024, 4096, (bf16_t*)(wb + W_DN) + (size_t)L * 1024 * 4096, 1024, 1024, 1024, lds);
  }
}

constexpr int G_OP = 256 * 64;
constexpr int G_STAGE = 2 * G_OP;
constexpr int G_NST = 4;
static_assert(G_NST * G_STAGE <= LDS_TILE_BYTES, "LDS ring");

DI void tile_map(int t, int Ntiles, int& mt, int& nt) {
  const int xcd = t & 7, j = t >> 3;
  const int per = 4 * Ntiles;
  const int g = j / per, r = j - g * per;
  nt = r >> 2;
  mt = (g * 4 + (r & 3)) * 8 + xcd;
}

template <bool ROWSS>
DI void frag_ss(const bf16x8& af, float& ss) {
  if (ROWSS) {
    typedef __bf16 bf2 __attribute__((ext_vector_type(2)));
    typedef __bf16 bf8 __attribute__((ext_vector_type(8)));
    const bf8 v = __builtin_bit_cast(bf8, af);
#pragma unroll
    for (int e = 0; e < 4; ++e) {
      const bf2 t = {v[2 * e], v[2 * e + 1]};
      ss = __builtin_amdgcn_fdot2_f32_bf16(t, t, ss, false);
    }
  }
}

DI void lds_barrier() {
  __builtin_amdgcn_s_waitcnt(0xC07F);
  __builtin_amdgcn_s_barrier();
  asm volatile("" ::: "memory");
}

template <bool ROWSS, class Epi>
DI void gemm_phase(const bf16_t* A, int lda, const bf16_t* Bt, int K, int Ntiles, const Epi& epi, unsigned char* lds) {
  const int tid = opaque_tid(), lane = tid & 63, w = tid >> 6, h = lane >> 5, r = lane & 31;
  const int wm = w & 3, wn = w >> 2;
  const int ntiles = (T / 256) * Ntiles;
  const int nk = K >> 5;
  const int fsw = (h ^ ((r >> 2) & 3)) * 16;
  const int a_off = (64 * wm + r) * 64 + fsw;
  const int b_off = G_OP + (128 * wn + r) * 64 + fsw;
  const int grow = lane >> 2, gch = ((lane & 3) ^ ((lane >> 4) & 3)) * 8;
  const int wu = __builtin_amdgcn_readfirstlane(w);
  int t = blockIdx.x;
  int m0 = 0, nt = 0;
  const bf16_t* ag = A;
  const bf16_t* bg = Bt;
  auto set_tile = [&](int tt) {
    int mt_;
    tile_map(tt, Ntiles, mt_, nt);
    m0 = mt_ * 256;
    ag = A + (size_t)(m0 + 16 * w + grow) * lda + gch;
    bg = Bt + (size_t)(nt * 256 + 16 * w + grow) * K + gch;
  };
  bool primed = false;
  while (t < ntiles) {
    auto glds1 = [&](int kt, int piece) {
      unsigned char* st = lds + (kt & (G_NST - 1)) * G_STAGE + wu * 1024;
      const int k0 = kt * 32;
      if (piece == 0) __builtin_amdgcn_global_load_lds((const unsigned*)(ag + k0), (unsigned*)(st), 16, 0, 0);
      if (piece == 1) __builtin_amdgcn_global_load_lds((const unsigned*)(ag + (size_t)128 * lda + k0), (unsigned*)(st + 8192), 16, 0, 0);
      if (piece == 2) __builtin_amdgcn_global_load_lds((const unsigned*)(bg + k0), (unsigned*)(st + G_OP), 16, 0, 0);
      if (piece == 3) __builtin_amdgcn_global_load_lds((const unsigned*)(bg + (size_t)128 * K + k0), (unsigned*)(st + G_OP + 8192), 16, 0, 0);
    };
    auto glds = [&](int kt) { glds1(kt, 0); glds1(kt, 1); glds1(kt, 2); glds1(kt, 3); };
    if (!primed) {
      set_tile(t);
      asm volatile("s_waitcnt vmcnt(0)" ::: "memory");
      glds(0); glds(1); glds(2);
      primed = true;
    }
    f32x16 acc[2][4];
#pragma unroll
    for (int mb = 0; mb < 2; ++mb)
#pragma unroll
      for (int nb = 0; nb < 4; ++nb) acc[mb][nb] = zero16();
    float ss0 = 0.f, ss1 = 0.f;
    bf16x8 af0[2], wf0[4], af1[2], wf1[4];
    for (int kt = 0; kt < nk; ++kt) {
      if (kt + 2 < nk) asm volatile("s_waitcnt vmcnt(4)" ::: "memory"); else asm volatile("s_waitcnt vmcnt(0)" ::: "memory");
      lds_barrier();
      const bool pf = kt + 3 < nk;
      const unsigned char* sc = lds + (kt & (G_NST - 1)) * G_STAGE;
      if (kt == 0) {
#pragma unroll
        for (int mb = 0; mb < 2; ++mb) af0[mb] = *(const bf16x8*)(sc + a_off + 2048 * mb);
#pragma unroll
        for (int nb = 0; nb < 4; ++nb) wf0[nb] = *(const bf16x8*)(sc + b_off + 2048 * nb);
      }
#pragma unroll
      for (int mb = 0; mb < 2; ++mb) af1[mb] = *(const bf16x8*)(sc + (a_off ^ 32) + 2048 * mb);
#pragma unroll
      for (int nb = 0; nb < 4; ++nb) wf1[nb] = *(const bf16x8*)(sc + (b_off ^ 32) + 2048 * nb);
      __builtin_amdgcn_sched_barrier(0);
      frag_ss<ROWSS>(af0[0], ss0);
      frag_ss<ROWSS>(af0[1], ss1);
#pragma unroll
      for (int nb = 0; nb < 4; ++nb) {
#pragma unroll
        for (int mb = 0; mb < 2; ++mb) acc[mb][nb] = MFMA(wf0[nb], af0[mb], acc[mb][nb]);
        if (nb == 1) { __builtin_amdgcn_sched_barrier(0); if (pf) glds1(kt + 3, 0); __builtin_amdgcn_sched_barrier(0); }
        if (nb == 3) { __builtin_amdgcn_sched_barrier(0); if (pf) glds1(kt + 3, 1); }
      }
      __builtin_amdgcn_sched_barrier(0);
      __builtin_amdgcn_sched_barrier(0);
      frag_ss<ROWSS>(af1[0], ss0);
      frag_ss<ROWSS>(af1[1], ss1);
#pragma unroll
      for (int nb = 0; nb < 4; ++nb) {
#pragma unroll
        for (int mb = 0; mb < 2; ++mb) acc[mb][nb] = MFMA(wf1[nb], af1[mb], acc[mb][nb]);
        if (nb == 0) {
          __builtin_amdgcn_sched_barrier(0);
          if (kt + 1 < nk) {
            const unsigned char* sn = lds + ((kt + 1) & (G_NST - 1)) * G_STAGE;
#pragma unroll
            for (int mb = 0; mb < 2; ++mb) af0[mb] = *(const bf16x8*)(sn + a_off + 2048 * mb);
#pragma unroll
            for (int nb2 = 0; nb2 < 4; ++nb2) wf0[nb2] = *(const bf16x8*)(sn + b_off + 2048 * nb2);
          }
          __builtin_amdgcn_sched_barrier(0);
        }
        if (nb == 1) { __builtin_amdgcn_sched_barrier(0); if (pf) glds1(kt + 3, 2); __builtin_amdgcn_sched_barrier(0); }
        if (nb == 3) { __builtin_amdgcn_sched_barrier(0); if (pf) glds1(kt + 3, 3); }
      }
      __builtin_amdgcn_sched_barrier(0);
    }
    lds_barrier();
    float rs0 = 1.f, rs1 = 1.f;
    if (ROWSS) {
      ss0 += xor32(ss0);
      ss1 += xor32(ss1);
      rs0 = rsqrtf(ss0 / (float)K + EPS);
      rs1 = rsqrtf(ss1 / (float)K + EPS);
    }
    const int mrow = m0 + 64 * wm + r, nt128 = 2 * nt + wn;
    t += gridDim.x;
    if (t < ntiles) { set_tile(t); glds(0); glds(1); glds(2); }
    epi(acc[0], mrow, nt128, h, rs0);
    epi(acc[1], mrow + 32, nt128, h, rs1);
  }
}

DI void swap8(const f32x16& a, int p, float (&v)[8]) {
#pragma unroll
  for (int e = 0; e < 4; ++e) {
    const auto r = __builtin_amdgcn_permlane32_swap(__float_as_uint(a[8 * p + e]), __float_as_uint(a[8 * p + 4 + e]), false, false);
    v[e] = __uint_as_float(r[0]);
    v[4 + e] = __uint_as_float(r[1]);
  }
}
DI u32x4 pk8(const float (&v)[8], float r, const float* gain) {
  float o[8];
  if (gain) {
    const f32x4 g0 = *(const f32x4*)(gain), g1 = *(const f32x4*)(gain + 4);
#pragma unroll
    for (int e = 0; e < 4; ++e) { o[e] = v[e] * r * g0[e]; o[4 + e] = v[4 + e] * r * g1[e]; }
  } else {
#pragma unroll
    for (int e = 0; e < 8; ++e) o[e] = v[e] * r;
  }
  return (u32x4){pack2(o[0], o[1]), pack2(o[2], o[3]), pack2(o[4], o[5]), pack2(o[6], o[7])};
}
DI void st8(bf16_t* p, const float (&v)[8], float r, const float* gain) {
  float o[8];
  if (gain) {
    const f32x4 g0 = *(const f32x4*)(gain), g1 = *(const f32x4*)(gain + 4);
#pragma unroll
    for (int e = 0; e < 4; ++e) { o[e] = v[e] * r * g0[e]; o[4 + e] = v[4 + e] * r * g1[e]; }
  } else {
#pragma unroll
    for (int e = 0; e < 8; ++e) o[e] = v[e] * r;
  }
  u32x4 u = {pack2(o[0], o[1]), pack2(o[2], o[3]), pack2(o[4], o[5]), pack2(o[6], o[7])};
  *(u32x4*)p = u;
}
constexpr int EPI_LDS = 3 * G_STAGE;
DI void stage_put(unsigned char* reg, int r, int chunk, const u32x4& o) { *(u32x4*)(reg + r * 128 + ((chunk ^ (r & 7)) << 4)) = o; }
DI void stage_flush(unsigned char* reg, bf16_t* dst0, size_t ld) {
  const int lane = opaque_tid() & 63;
  __builtin_amdgcn_s_waitcnt(0xC07F);
#pragma unroll
  for (int q = 0; q < 4; ++q) {
    const int row = 8 * q + (lane >> 3), phys = lane & 7;
    const u32x4 v = *(const u32x4*)(reg + row * 128 + (phys << 4));
    *(u32x4*)(dst0 + (size_t)row * ld + ((phys ^ (row & 7)) << 3)) = v;
  }
  __builtin_amdgcn_s_waitcnt(0xC07F);
  __builtin_amdgcn_sched_barrier(0);
}
struct EpiResid {
  const float* res_f32; bf16_t* xb; float* out_f32; unsigned char* lds;
  DI void operator()(f32x16 (&acc)[4], int m, int nt, int h, float) const {
    const size_t base = (size_t)m * DM + nt * 128;
    const int r = m & 31;
    unsigned char* reg = lds + EPI_LDS + (opaque_tid() >> 6) * 4096;
#pragma unroll
    for (int nb = 0; nb < 4; ++nb) {
#pragma unroll
      for (int p = 0; p < 2; ++p) {
        const int c = 32 * nb + 8 * (2 * p + h);
        float v[8];
        swap8(acc[nb], p, v);
        if (res_f32) {
          const f32x4 r0 = *(const f32x4*)(res_f32 + base + c), r1 = *(const f32x4*)(res_f32 + base + c + 4);
#pragma unroll
          for (int e = 0; e < 4; ++e) { v[e] += r0[e]; v[4 + e] += r1[e]; }
        } else {
          const u32x4 u = *(const u32x4*)(xb + base + c);
#pragma unroll
          for (int e = 0; e < 4; ++e) { v[2 * e] += __uint_as_float(u[e] << 16); v[2 * e + 1] += __uint_as_float(u[e] & 0xffff0000u); }
        }
        if (out_f32) {
          *(f32x4*)(out_f32 + base + c) = (f32x4){v[0], v[1], v[2], v[3]};
          *(f32x4*)(out_f32 + base + c + 4) = (f32x4){v[4], v[5], v[6], v[7]};
        } else {
          const u32x4 o = {pack2(v[0], v[1]), pack2(v[2], v[3]), pack2(v[4], v[5]), pack2(v[6], v[7])};
          stage_put(reg, r, 4 * (nb & 1) + 2 * p + h, o);
        }
      }
      if (!out_f32 && (nb & 1)) stage_flush(reg, xb + (size_t)(m - r) * DM + nt * 128 + 64 * (nb >> 1), DM);
    }
  }
};
struct EpiRelu2 {
  bf16_t* hid; unsigned char* lds;
  DI void operator()(f32x16 (&acc)[4], int m, int nt, int h, float rs) const {
    const int r = m & 31;
    unsigned char* reg = lds + EPI_LDS + (opaque_tid() >> 6) * 4096;
    bf16_t* blk = hid + (size_t)(m - r) * DFF + nt * 128;
#pragma unroll
    for (int ch = 0; ch < 2; ++ch) {
#pragma unroll
      for (int nb2 = 0; nb2 < 2; ++nb2)
#pragma unroll
        for (int p = 0; p < 2; ++p) {
          float v[8];
          swap8(acc[2 * ch + nb2], p, v);
#pragma unroll
          for (int e = 0; e < 8; ++e) { const float a = fmaxf(v[e] * rs, 0.f); v[e] = a * a; }
          const u32x4 o = {pack2(v[0], v[1]), pack2(v[2], v[3]), pack2(v[4], v[5]), pack2(v[6], v[7])};
          stage_put(reg, r, 4 * nb2 + 2 * p + h, o);
        }
      stage_flush(reg, blk + 64 * ch, DFF);
    }
  }
};
constexpr float QS_64 = 0.125f * LOG2E;
constexpr float QS_96 = 0.10206207261596575f * LOG2E;

struct EpiEvenIn {
  bf16_t* hb; const float *a_qg, *a_kg, *b_ckvg; unsigned char* lds;
  DI void operator()(f32x16 (&acc)[4], int m, int nt, int h, float rs) const {
    const int b = m >> 13, s = m & (S - 1);
    unsigned char* sreg = lds + EPI_LDS + (opaque_tid() >> 6) * 4096;
    if (nt < 6) {
#pragma unroll
      for (int hh = 0; hh < 2; ++hh) {
        float r = rs;
        const float* gain = nullptr;
        bf16_t* dst;
        if (nt < 5) {
          float ss = 0.f;
#pragma unroll
          for (int x = 0; x < 2; ++x)
#pragma unroll
            for (int i = 0; i < 16; ++i) { const float v = acc[2 * hh + x][i] * rs; ss = fmaf(v, v, ss); }
          ss += xor32(ss);
          r = rsqrtf(ss * (1.f / 64.f) + EPS) * rs;
          if (nt < 4) { gain = a_qg; r *= QS_64; } else gain = a_kg;
        }
        {
          const size_t off = (nt < 4) ? E_QA + ((size_t)(b * 8 + 2 * nt + hh) * S + s) * 64
                                      : E_KA + (size_t)(nt - 4) * (TE * 128) + ((size_t)(b * 2 + hh) * S + s) * 64;
          dst = hb + off;
        }
#pragma unroll
        for (int x = 0; x < 2; ++x)
#pragma unroll
          for (int pq = 0; pq < 2; ++pq) {
            const int d = 32 * x + 8 * (2 * pq + h);
            float v[8];
            swap8(acc[2 * hh + x], pq, v);
            stage_put(sreg, m & 31, 4 * x + 2 * pq + h, pk8(v, r, gain ? gain + d : nullptr));
          }
        stage_flush(sreg, dst - (m & 31) * 64, 64);
      }
    } else if (nt < 8) {
      bf16_t* dst = hb + E_CQ + (size_t)m * 256 + (nt - 6) * 128;
#pragma unroll
      for (int nb = 0; nb < 4; ++nb) {
#pragma unroll
        for (int pq = 0; pq < 2; ++pq) {
          float v[8];
          swap8(acc[nb], pq, v);
          stage_put(sreg, m & 31, 4 * (nb & 1) + 2 * pq + h, pk8(v, rs, nullptr));
        }
        if (nb & 1) stage_flush(sreg, dst - (size_t)(m & 31) * 256 + 64 * (nb >> 1), 256);
      }
    } else if (nt == 8) {
      float ss = 0.f;
#pragma unroll
      for (int nb = 0; nb < 4; ++nb)
#pragma unroll
        for (int i = 0; i < 16; ++i) { const float v = acc[nb][i] * rs; ss = fmaf(v, v, ss); }
      ss += xor32(ss);
      const float r = rsqrtf(ss * (1.f / 128.f) + EPS) * rs;
      bf16_t* dst = hb + E_CKV + (size_t)m * 128;
#pragma unroll
      for (int nb = 0; nb < 4; ++nb) {
#pragma unroll
        for (int pq = 0; pq < 2; ++pq) {
          const int c = 32 * nb + 8 * (2 * pq + h);
          float v[8];
          swap8(acc[nb], pq, v);
          stage_put(sreg, m & 31, 4 * (nb & 1) + 2 * pq + h, pk8(v, r, b_ckvg + c));
        }
        if (nb & 1) stage_flush(sreg, dst - (size_t)(m & 31) * 128 + 64 * (nb >> 1), 128);
      }
    } else {
      float* dst = (float*)(hb + E_KR) + (size_t)m * 32;
#pragma unroll
      for (int g = 0; g < 4; ++g) {
        f32x4 v = {acc[0][4 * g] * rs, acc[0][4 * g + 1] * rs, acc[0][4 * g + 2] * rs, acc[0][4 * g + 3] * rs};
        *(f32x4*)(dst + 8 * g + 4 * h) = v;
      }
    }
  }
};

DI void sincos_cw(float x, float& sn, float& cs) {
  const float k = rintf(x * 0.63661977236758134f);
  float r = fmaf(-k, 1.57079637050628662109375f, x);
  r = fmaf(-k, -4.37113900018624283e-8f, r);
  const int q = (int)k;
  const float r2 = r * r;
  const float sp = fmaf(r * r2, fmaf(r2, fmaf(r2, -1.9515295891e-4f, 8.3321608736e-3f), -1.6666654611e-1f), r);
  const float cp = fmaf(r2 * r2, fmaf(r2, fmaf(r2, 2.443315711809948e-5f, -1.388731625493765e-3f), 4.166664568298827e-2f), fmaf(r2, -0.5f, 1.f));
  const float s0 = (q & 1) ? cp : sp, c0 = (q & 1) ? sp : cp;
  sn = (q & 2) ? -s0 : s0;
  cs = ((q + 1) & 2) ? -c0 : c0;
}
DI constexpr float rope_inv(int i) {
  return i == 0 ? 1.f : i == 1 ? 0.5623413251903491f : i == 2 ? 0.31622776601683794f : i == 3 ? 0.1778279410038923f : i == 4 ? 0.1f
       : i == 5 ? 0.05623413251903491f : i == 6 ? 0.031622776601683794f : i == 7 ? 0.01778279410038923f : i == 8 ? 0.01f
       : i == 9 ? 0.005623413251903491f : i == 10 ? 0.0031622776601683794f : i == 11 ? 0.001778279410038923f : i == 12 ? 0.001f
       : i == 13 ? 0.0005623413251903491f : i == 14 ? 0.00031622776601683794f : 0.0001778279410038923f;
}
DI void rope4(const float (&y1)[4], const float (&y2)[4], int gg, int h, float posf, float (&o1)[4], float (&o2)[4]) {
#pragma unroll
  for (int e = 0; e < 4; ++e) {
    const float inv = h ? rope_inv(8 * gg + 4 + e) : rope_inv(8 * gg + e);
    const float ang = posf * inv;
    float sn, cs;
    sincos_cw(ang, sn, cs);
    o1[e] = y1[e] * cs - y2[e] * sn;
    o2[e] = y1[e] * sn + y2[e] * cs;
  }
}

struct EpiUQ {
  bf16_t* QB; const float* b_qg; const int* pos;
  DI void operator()(f32x16 (&acc)[4], int m, int nt, int h, float rs) const {
    const int b = m >> 13, s = m & (S - 1);
    float ss = 0.f;
#pragma unroll
    for (int nb = 0; nb < 3; ++nb)
#pragma unroll
      for (int i = 0; i < 16; ++i) { const float v = acc[nb][i] * rs; ss = fmaf(v, v, ss); }
    ss += xor32(ss);
    const float r = rsqrtf(ss * (1.f / 96.f) + EPS) * rs * QS_96;
    bf16_t* dst = QB + ((size_t)(b * 8 + nt) * S + s) * 96;
#pragma unroll
    for (int nb = 0; nb < 2; ++nb)
#pragma unroll
      for (int pq = 0; pq < 2; ++pq) {
        const int c = 32 * nb + 8 * (2 * pq + h);
        float v[8];
        swap8(acc[nb], pq, v);
        st8(dst + c, v, r, b_qg + c);
      }
    const float posf = (float)pos[m];
#pragma unroll
    for (int gg = 0; gg < 2; ++gg) {
      const int ri0 = 8 * gg + 4 * h;
      const f32x4 g1 = *(const f32x4*)(b_qg + 64 + ri0), g2 = *(const f32x4*)(b_qg + 80 + ri0);
      float y1[4], y2[4], o1[4], o2[4];
#pragma unroll
      for (int e = 0; e < 4; ++e) { y1[e] = acc[2][4 * gg + e] * r * g1[e]; y2[e] = acc[2][4 * gg + 8 + e] * r * g2[e]; }
      rope4(y1, y2, gg, h, posf, o1, o2);
      st4(dst + 64 + ri0, o1[0], o1[1], o1[2], o1[3]);
      st4(dst + 80 + ri0, o2[0], o2[1], o2[2], o2[3]);
    }
  }
};

struct EpiUKV {
  bf16_t *KB, *VB; const float* KR; const float* b_kg; const int* pos;
  DI void operator()(f32x16 (&acc)[4], int m, int nt, int h, float) const {
    const int b = m >> 13, s = m & (S - 1);
    f32x4 k1[2], k2[2];
    float ss = 0.f;
#pragma unroll
    for (int gg = 0; gg < 2; ++gg) {
      k1[gg] = *(const f32x4*)(KR + (size_t)m * 32 + 8 * gg + 4 * h);
      k2[gg] = *(const f32x4*)(KR + (size_t)m * 32 + 16 + 8 * gg + 4 * h);
#pragma unroll
      for (int e = 0; e < 4; ++e) { ss = fmaf(k1[gg][e], k1[gg][e], ss); ss = fmaf(k2[gg][e], k2[gg][e], ss); }
    }
#pragma unroll
    for (int nb = 0; nb < 2; ++nb)
#pragma unroll
      for (int i = 0; i < 16; ++i) ss = fmaf(acc[nb][i], acc[nb][i], ss);
    ss += xor32(ss);
    const float r = rsqrtf(ss * (1.f / 96.f) + EPS);
    bf16_t* dst = KB + ((size_t)(b * 8 + nt) * S + s) * 96;
#pragma unroll
    for (int nb = 0; nb < 2; ++nb)
#pragma unroll
      for (int pq = 0; pq < 2; ++pq) {
        const int c = 32 * nb + 8 * (2 * pq + h);
        float v[8];
        swap8(acc[nb], pq, v);
        st8(dst + c, v, r, b_kg + c);
      }
    const float posf = (float)pos[m];
#pragma unroll
    for (int gg = 0; gg < 2; ++gg) {
      const int ri0 = 8 * gg + 4 * h;
      const f32x4 g1 = *(const f32x4*)(b_kg + 64 + ri0), g2 = *(const f32x4*)(b_kg + 80 + ri0);
      float y1[4], y2[4], o1[4], o2[4];
#pragma unroll
      for (int e = 0; e < 4; ++e) { y1[e] = k1[gg][e] * r * g1[e]; y2[e] = k2[gg][e] * r * g2[e]; }
      rope4(y1, y2, gg, h, posf, o1, o2);
      st4(dst + 64 + ri0, o1[0], o1[1], o1[2], o1[3]);
      st4(dst + 80 + ri0, o2[0], o2[1], o2[2], o2[3]);
    }
    bf16_t* vd = VB + ((size_t)(b * 8 + nt) * S + s) * 64;
#pragma unroll
    for (int nb = 2; nb < 4; ++nb)
#pragma unroll
      for (int pq = 0; pq < 2; ++pq) {
        float v[8];
        swap8(acc[nb], pq, v);
        st8(vd + 32 * (nb - 2) + 8 * (2 * pq + h), v, 1.f, nullptr);
      }
  }
};

struct EpiOddIn {
  bf16_t* hb; const float *d_qg, *d_kg; unsigned char* lds;
  DI void operator()(f32x16 (&acc)[4], int m, int nt, int h, float rs) const {
    const int b = m >> 13, s = m & (S - 1);
    unsigned char* sreg = lds + EPI_LDS + (opaque_tid() >> 6) * 4096;
    const int region = nt >> 2, r4 = nt & 3;
    if (region < 5) {
#pragma unroll
      for (int hh = 0; hh < 2; ++hh) {
        float r = rs;
        const float* gain = nullptr;
        bf16_t* dst;
        if (region < 3) {
          if (region == 0) r *= QS_64;
          dst = hb + (size_t)region * (TE * 512) + ((size_t)(b * 8 + 2 * r4 + hh) * S + s) * 64;
        } else {
          float ss = 0.f;
#pragma unroll
          for (int x = 0; x < 2; ++x)
#pragma unroll
            for (int i = 0; i < 16; ++i) { const float v = acc[2 * hh + x][i] * rs; ss = fmaf(v, v, ss); }
          ss += xor32(ss);
          r = rsqrtf(ss * (1.f / 64.f) + EPS) * rs;
          if (region == 3) { gain = d_qg + hh * 64; r *= QS_64; } else gain = d_kg + hh * 64;
          dst = hb + (size_t)region * (TE * 512) + ((size_t)((b * 4 + r4) * 2 + hh) * S + s) * 64;
        }
#pragma unroll
        for (int x = 0; x < 2; ++x)
#pragma unroll
          for (int pq = 0; pq < 2; ++pq) {
            const int d = 32 * x + 8 * (2 * pq + h);
            float v[8];
            swap8(acc[2 * hh + x], pq, v);
            stage_put(sreg, m & 31, 4 * x + 2 * pq + h, pk8(v, r, gain ? gain + d : nullptr));
          }
        stage_flush(sreg, dst - (m & 31) * 64, 64);
      }
    } else {
      bf16_t* dst = hb + O_VD + ((size_t)(b * 4 + r4) * S + s) * 128;
#pragma unroll
      for (int nb = 0; nb < 4; ++nb) {
#pragma unroll
        for (int pq = 0; pq < 2; ++pq) {
          float v[8];
          swap8(acc[nb], pq, v);
          stage_put(sreg, m & 31, 4 * (nb & 1) + 2 * pq + h, pk8(v, rs, nullptr));
        }
        if (nb & 1) stage_flush(sreg, dst - (size_t)(m & 31) * 128 + 64 * (nb >> 1), 128);
      }
    }
  }
};

template <int DQK, int DV>
struct AL {
  static constexpr int KSTR = DQK * 2 + 16, VSTR = DV * 2 + 64, KBYTES = 64 * KSTR, VBYTES = 64 * VSTR, STAGE = KBYTES + VBYTES;
  static constexpr int KCH = DQK / 8, VCH = DV / 8;
  static constexpr int NKC = 8 * DQK, NVC = 8 * DV;
  static constexpr int NKR = (NKC + NT - 1) / NT, NVR = (NVC + NT - 1) / NT;
};

template <int DQK, int DV>
DI void a_gload(const bf16_t* Kt, const bf16_t* Vt, u32x4 (&rk)[AL<DQK, DV>::NKR], u32x4 (&rv)[AL<DQK, DV>::NVR], int tid) {
  typedef AL<DQK, DV> L;
#pragma unroll
  for (int q = 0; q < L::NKR; ++q) {
    const int c = tid + NT * q;
    if (c < L::NKC) rk[q] = *(const u32x4*)(Kt + (size_t)c * 8);
  }
#pragma unroll
  for (int q = 0; q < L::NVR; ++q) {
    const int c = tid + NT * q;
    if (c < L::NVC) rv[q] = *(const u32x4*)(Vt + (size_t)c * 8);
  }
}
template <int DQK, int DV>
DI void a_swrite(unsigned char* kl, unsigned char* vl, const u32x4 (&rk)[AL<DQK, DV>::NKR], const u32x4 (&rv)[AL<DQK, DV>::NVR], int tid) {
  typedef AL<DQK, DV> L;
#pragma unroll
  for (int q = 0; q < L::NKR; ++q) {
    const int c = tid + NT * q, row = c / L::KCH, cc = c - row * L::KCH;
    if (c < L::NKC) *(u32x4*)(kl + row * L::KSTR + cc * 16) = rk[q];
  }
#pragma unroll
  for (int q = 0; q < L::NVR; ++q) {
    const int c = tid + NT * q, row = c / L::VCH, cc = c - row * L::VCH;
    if (c < L::NVC) *(u32x4*)(vl + row * L::VSTR + cc * 16) = rv[q];
  }
}

template <int DV, int VSTR>
DI void v_load(const unsigned char* vl, int kb, int lane, bf16x8 (&vf)[2][DV / 32]) {
  const int h = lane >> 5, blk = (lane >> 4) & 1, q = (lane & 15) >> 2, pp = lane & 3;
  const unsigned char* a0 = vl + (32 * kb + 4 * h + q) * VSTR + (16 * blk + 4 * pp) * 2;
#pragma unroll
  for (int s2 = 0; s2 < 2; ++s2)
#pragma unroll
    for (int db = 0; db < DV / 32; ++db) {
      const unsigned char* a = a0 + 16 * s2 * VSTR + 64 * db;
      const s16x4 lo = __builtin_amdgcn_ds_read_tr16_b64_v4i16((LDS_AS s16x4*)(a));
      const s16x4 hi = __builtin_amdgcn_ds_read_tr16_b64_v4i16((LDS_AS s16x4*)(a + 8 * VSTR));
      vf[s2][db] = __builtin_shufflevector(lo, hi, 0, 1, 2, 3, 4, 5, 6, 7);
    }
}
template <int DV>
DI void pv_mma(const f32x16& p, const bf16x8 (&vf)[2][DV / 32], f32x16 (&O)[DV / 32]) {
#pragma unroll
  for (int s2 = 0; s2 < 2; ++s2) {
    const bf16x8 pf = pack8(p, 8 * s2);
#pragma unroll
    for (int db = 0; db < DV / 32; ++db) O[db] = MFMA(vf[s2][db], pf, O[db]);
  }
}

template <int MODE>
DI void attn_unit(const bf16_t* Qs, const bf16_t* Ks, const bf16_t* Vs, const bf16_t* Qs2, const bf16_t* Ks2, int qi, float slope2, float m0init,
                  float lam, float outscale, const float* subln, bf16_t* mixdst, float* stash, unsigned char* lds, float bnd0 = 0.f, float bnd1 = 0.f) {
  constexpr int DQK = (MODE == 1) ? 96 : 64, DV = (MODE == 3) ? 128 : 64, NDB = DV / 32, NKS = DQK / 16;
  typedef AL<DQK, DV> L;
  const int tid = opaque_tid(), lane = tid & 63, w = tid >> 6, h = lane >> 5, r = lane & 31;
  const int q0 = qi * 256;
  const int qrow = q0 + 32 * w + r;
  const int cw = (q0 + 32 * w) >> 6;
  const int gbw = (q0 + 32 * w) >> 5;
  const int jhi = 4 * qi + 3;
  int jlo = 0;
  if (MODE == 0) jlo = (4 * qi - 2) > 0 ? (4 * qi - 2) : 0;
  const int ntl = jhi - jlo + 1;
  constexpr int NPASS = (MODE == 3) ? 2 : 1;
#pragma unroll
  for (int pass = 0; pass < NPASS; ++pass) {
    const bf16_t* Qp = pass ? Qs2 : Qs;
    const bf16_t* Kp = pass ? Ks2 : Ks;
    bf16x8 qf[NKS];
#pragma unroll
    for (int s = 0; s < NKS; ++s) qf[s] = *(const bf16x8*)(Qp + (size_t)qrow * DQK + 16 * s + 8 * h);
    f32x16 O[NDB];
#pragma unroll
    for (int db = 0; db < NDB; ++db) O[db] = zero16();
    float m = (MODE == 0) ? m0init : -1e30f;
    float l = (MODE == 0 && h == 0) ? 1.f : 0.f;
    float c = 0.f;
    u32x4 rk[L::NKR], rv[L::NVR];
    {
      const int j0 = (MODE >= 2) ? jhi : jlo;
      a_gload<DQK, DV>(Kp + (size_t)j0 * 64 * DQK, Vs + (size_t)j0 * 64 * DV, rk, rv, tid);
      a_swrite<DQK, DV>(lds, lds + L::KBYTES, rk, rv, tid);
    }
    __builtin_amdgcn_s_waitcnt(0x0F70);
    __syncthreads();
    for (int it = 0; it < ntl; ++it) {
      const int j = (MODE >= 2) ? jhi - it : jlo + it;
      const bool more = it + 1 < ntl;
      if (more) {
        const int jn = (MODE >= 2) ? j - 1 : j + 1;
        a_gload<DQK, DV>(Kp + (size_t)jn * 64 * DQK, Vs + (size_t)jn * 64 * DV, rk, rv, tid);
      }
      const unsigned char* kl = lds + (it & 1) * L::STAGE;
      const unsigned char* vl = kl + L::KBYTES;
      if (MODE != 2) {
        const bool ok = (j <= cw) && (MODE != 0 || j >= cw - 2);
        if (ok && DV == 64) {
          f32x16 sc0 = zero16(), sc1 = zero16();
          bf16x8 vfa[2][NDB], vfb[2][NDB];
          {
            const unsigned char* kp = kl + r * L::KSTR + 16 * h;
            bf16x8 kf[NKS], kg[NKS];
#pragma unroll
            for (int s = 0; s < NKS; ++s) kf[s] = *(const bf16x8*)(kp + 32 * s);
            __builtin_amdgcn_sched_barrier(0);
#pragma unroll
            for (int s = 0; s < NKS; ++s) kg[s] = *(const bf16x8*)(kp + 32 * L::KSTR + 32 * s);
            __builtin_amdgcn_sched_barrier(0);
#pragma unroll
            for (int s = 0; s < NKS; ++s) sc0 = MFMA(kf[s], qf[s], sc0);
            __builtin_amdgcn_sched_barrier(0);
            v_load<DV, L::VSTR>(vl, 0, lane, vfa);
            v_load<DV, L::VSTR>(vl, 1, lane, vfb);
            __builtin_amdgcn_sched_barrier(0);
#pragma unroll
            for (int s = 0; s < NKS; ++s) sc1 = MFMA(kg[s], qf[s], sc1);
            __builtin_amdgcn_sched_barrier(0);
          }
          if (MODE == 0) {
            const float fl = (float)(qrow - (64 * j + 4 * h));
#pragma unroll
            for (int i = 0; i < 16; ++i) {
              sc0[i] = fmaf(-slope2, fabsf(fl - (float)((i & 3) + 8 * (i >> 2))), sc0[i]);
              sc1[i] = fmaf(-slope2, fabsf(fl - (float)(32 + (i & 3) + 8 * (i >> 2))), sc1[i]);
            }
          }
          float mx = fmaxf(sc0[0], sc1[0]);
#pragma unroll
          for (int i = 1; i < 16; ++i) mx = fmaxf(mx, fmaxf(sc0[i], sc1[i]));
          mx = fmaxf(mx, xor32(mx));
          const float mn = fmaxf(m, mx);
          if (__any(mn > m)) {
            const float alpha = ex2(m - mn);
            l *= alpha;
#pragma unroll
            for (int db = 0; db < NDB; ++db) O[db] = O[db] * alpha;
          }
          m = mn;
          float ps = 0.f;
#pragma unroll
          for (int i = 0; i < 16; ++i) { const float pe = ex2(sc0[i] - mn); sc0[i] = pe; ps += pe; }
          pv_mma<DV>(sc0, vfa, O);
#pragma unroll
          for (int i = 0; i < 16; ++i) { const float pe = ex2(sc1[i] - mn); sc1[i] = pe; ps += pe; }
          l += ps;
          pv_mma<DV>(sc1, vfb, O);
        } else if (ok) {
#pragma unroll 1
          for (int kb = 0; kb < 2; ++kb) {
            const unsigned char* kp = kl + (32 * kb + r) * L::KSTR + 16 * h;
            bf16x8 kf[NKS];
#pragma unroll
            for (int s = 0; s < NKS; ++s) kf[s] = *(const bf16x8*)(kp + 32 * s);
            bf16x8 vf[2][NDB];
            v_load<DV, L::VSTR>(vl, kb, lane, vf);
            __builtin_amdgcn_sched_barrier(0);
            const float fl = (float)(qrow - (64 * j + 32 * kb + 4 * h));
            const bool far = (MODE == 0 || MODE == 3) && (64 * j + 32 * kb + 31 < q0 + 32 * w);
            const float sl_i = far ? slope2 : 0.f;
            f32x16 sc;
#pragma unroll
            for (int i = 0; i < 16; ++i) sc[i] = sl_i * (float)((i & 3) + 8 * (i >> 2));
#pragma unroll
            for (int s = 0; s < NKS; ++s) sc = MFMA(kf[s], qf[s], sc);
            if ((MODE == 0 || MODE == 3) && !far) {
#pragma unroll
              for (int i = 0; i < 16; ++i) sc[i] = fmaf(-slope2, fabsf(fl - (float)((i & 3) + 8 * (i >> 2))), sc[i]);
            }
            const float u = far ? -slope2 * fl : 0.f;
            float mx = sc[0];
#pragma unroll
            for (int i = 1; i < 16; ++i) mx = fmaxf(mx, sc[i]);
            mx += u;
            mx = fmaxf(mx, xor32(mx));
            const float mn = fmaxf(m, mx);
            if (__any(mn > m)) {
              const float alpha = ex2(m - mn);
              l *= alpha;
#pragma unroll
              for (int db = 0; db < NDB; ++db) O[db] = O[db] * alpha;
            }
            m = mn;
            const float shift = mn - u;
            float ps = 0.f;
#pragma unroll
            for (int i = 0; i < 16; ++i) { const float pe = ex2(sc[i] - shift); sc[i] = pe; ps += pe; }
            l += ps;
            pv_mma<DV>(sc, vf, O);
          }
        }
      } else {
#pragma unroll 1
        for (int kk = 0; kk < 2; ++kk) {
          const int kb = 1 - kk;
          const int gb = 2 * j + kb;
          if (gb <= gbw) {
            const bool diag = gb == gbw;
            const unsigned char* kp = kl + (32 * kb + r) * L::KSTR + 16 * h;
            bf16x8 kf[NKS];
#pragma unroll
            for (int s = 0; s < NKS; ++s) kf[s] = *(const bf16x8*)(kp + 32 * s);
            bf16x8 vf[2][NDB];
            v_load<DV, L::VSTR>(vl, kb, lane, vf);
            __builtin_amdgcn_sched_barrier(0);
            f32x16 z = zero16();
#pragma unroll
            for (int s = 0; s < NKS; ++s) z = MFMA(kf[s], qf[s], z);
            f32x16 sp;
#pragma unroll
            for (int i = 0; i < 16; ++i) {
              const float zi = z[i];
              const float e = ex2(-fabsf(zi));
              float v = fmaxf(zi, 0.f) + lg2(1.f + e);
              const int key = (i & 3) + 8 * (i >> 2) + 4 * h;
              if (diag && key >= r) v = 0.f;
              sp[i] = v;
            }
            float Tg[4], Tp[4], offs[4];
#pragma unroll
            for (int g = 0; g < 4; ++g) { Tg[g] = (sp[4 * g] + sp[4 * g + 1]) + (sp[4 * g + 2] + sp[4 * g + 3]); Tp[g] = xor32(Tg[g]); }
            float run = 0.f;
#pragma unroll
            for (int g = 3; g >= 0; --g) { offs[g] = run + (h == 0 ? Tp[g] : 0.f); run += Tg[g] + Tp[g]; }
#pragma unroll
            for (int g = 3; g >= 0; --g) {
              float a = c + offs[g];
#pragma unroll
              for (int e = 3; e >= 0; --e) {
                const int i = 4 * g + e;
                a += sp[i];
                float pe = ex2(z[i] - a);
                const int key = (i & 3) + 8 * (i >> 2) + 4 * h;
                if (diag && key >= r) pe = 0.f;
                z[i] = pe;
              }
            }
            c += run;
            pv_mma<DV>(z, vf, O);
          }
        }
      }
      if (more) {
        unsigned char* kn = lds + ((it + 1) & 1) * L::STAGE;
        a_swrite<DQK, DV>(kn, kn + L::KBYTES, rk, rv, tid);
      }
      if (MODE == 3) {
        volatile int* fl = (volatile int*)(lds + LDS_TILE_BYTES) + (it & 1) * 8;
        const float dmin = (float)((q0 + 32 * w) - (64 * j - 1));
        const float bnd = pass ? bnd1 : bnd0;
        const int done = __all(bnd - slope2 * dmin < m - 150.f) ? 1 : 0;
        if (lane == 0) fl[w] = done;
        __syncthreads();
        if (fl[0] + fl[1] + fl[2] + fl[3] + fl[4] + fl[5] + fl[6] + fl[7] == 8) break;
      } else if (MODE == 2) {
        volatile int* fl = (volatile int*)(lds + LDS_TILE_BYTES) + (it & 1) * 8;
        const int done = __all(c > 160.f) ? 1 : 0;
        if (lane == 0) fl[w] = done;
        __syncthreads();
        if (fl[0] + fl[1] + fl[2] + fl[3] + fl[4] + fl[5] + fl[6] + fl[7] == 8) break;
      } else
        __syncthreads();
    }
    bf16_t* orow = mixdst + (size_t)(32 * w + r) * DM;
    if (MODE == 2) {
#pragma unroll
      for (int db = 0; db < NDB; ++db)
#pragma unroll
        for (int pq = 0; pq < 2; ++pq) {
          float v[8];
          swap8(O[db], pq, v);
          st8(orow + 32 * db + 8 * (2 * pq + h), v, 1.f, nullptr);
        }
    } else {
      const float lt = l + xor32(l);
      const float inv = 1.f / lt;
      if (MODE != 3) {
#pragma unroll
        for (int db = 0; db < NDB; ++db)
#pragma unroll
          for (int pq = 0; pq < 2; ++pq) {
            float v[8];
            swap8(O[db], pq, v);
            st8(orow + 32 * db + 8 * (2 * pq + h), v, inv, nullptr);
          }
      } else if (pass == 0) {
#pragma unroll
        for (int db = 0; db < NDB; ++db)
#pragma unroll
          for (int g = 0; g < 4; ++g) {
            f32x4 v = {O[db][4 * g] * inv, O[db][4 * g + 1] * inv, O[db][4 * g + 2] * inv, O[db][4 * g + 3] * inv};
            *(f32x4*)(stash + tid * 64 + db * 16 + 4 * g) = v;
          }
      } else {
        const float li = lam * inv;
        float ss = 0.f;
#pragma unroll
        for (int db = 0; db < NDB; ++db)
#pragma unroll
          for (int g = 0; g < 4; ++g) {
            const f32x4 o1 = *(const f32x4*)(stash + tid * 64 + db * 16 + 4 * g);
#pragma unroll
            for (int e = 0; e < 4; ++e) { const float v = o1[e] - li * O[db][4 * g + e]; O[db][4 * g + e] = v; ss = fmaf(v, v, ss); }
          }
        ss += xor32(ss);
        const float rr = rsqrtf(ss * (1.f / 128.f) + EPS) * outscale;
#pragma unroll
        for (int db = 0; db < NDB; ++db)
#pragma unroll
          for (int pq = 0; pq < 2; ++pq) {
            const int d = 32 * db + 8 * (2 * pq + h);
            float v[8];
            swap8(O[db], pq, v);
            st8(orow + d, v, rr, subln + d);
          }
      }
    }
  }
}

DI int next_unit(int* ctr, unsigned char* lds) {
  volatile int* slot = (volatile int*)(lds + LDS_TILE_BYTES + 64);
  if (threadIdx.x == 0) *slot = atomicAdd(ctr, 1);
  __syncthreads();
  const int u = *slot;
  __syncthreads();
  return u;
}

DI void attn_even(const Params& p, int j, int*  , unsigned char* lds) {
  bf16_t* hb = (bf16_t*)(p.ws + WS_HID);
  bf16_t* mix = (bf16_t*)(p.ws + WS_MIX);
  int* qbase = (int*)(p.ws + WS_CTR) + 16 + j * 8;
  for (int xo = 0; xo < 8; ++xo) {
    const int hd = (blockIdx.x + xo) & 7;
    for (;;) {
      int v = next_unit(qbase + hd, lds);
      if (v >= 256) break;
      if (v < 128) {
        const int qi = 31 - (v >> 2), b = v & 3;
        const size_t sl = (size_t)(b * 8 + hd) * S;
        attn_unit<1>(hb + E_QB + sl * 96, hb + E_KB + sl * 96, hb + E_VB + sl * 64, nullptr, nullptr, qi, 0.f, 0.f, 0.f, 0.f, nullptr,
                     mix + ((size_t)b * S + qi * 256) * DM + 512 + hd * 64, nullptr, lds);
      } else {
        v -= 128;
        const int qi = 31 - (v >> 2), b = v & 3, g = hd >> 2;
        const size_t sl = (size_t)(b * 8 + hd) * S, slk = (size_t)(b * 2 + g) * S;
        const float slope2 = exp2f(-(float)(hd + 1)) * LOG2E;
        const float m0 = p.in[10][j * 8 + hd] * LOG2E;
        attn_unit<0>(hb + E_QA + sl * 64, hb + E_KA + slk * 64, hb + E_VA + slk * 64, nullptr, nullptr, qi, slope2, m0, 0.f, 0.f, nullptr,
                     mix + ((size_t)b * S + qi * 256) * DM + hd * 64, nullptr, lds);
      }
    }
  }
}

DI void attn_odd(const Params& p, int j, int* ctr, unsigned char* lds) {
  bf16_t* hb = (bf16_t*)(p.ws + WS_HID);
  bf16_t* mix = (bf16_t*)(p.ws + WS_MIX);
  const float* lf = p.in[21] + j * 256;
  float d01 = 0.f, d23 = 0.f;
  for (int i = 0; i < 64; ++i) { d01 = fmaf(lf[i], lf[64 + i], d01); d23 = fmaf(lf[128 + i], lf[192 + i], d23); }
  const float lambda_init = 0.8f - 0.6f * expf(-0.3f * (float)(2 * j + 1));
  const float lam = expf(d01) - expf(d23) + lambda_init;
  float bnd[2];
  for (int wh = 0; wh < 2; ++wh) {
    float gq = 0.f, gk = 0.f;
    for (int i = 0; i < 64; ++i) { gq = fmaxf(gq, fabsf(p.in[19][j * 128 + wh * 64 + i])); gk = fmaxf(gk, fabsf(p.in[20][j * 128 + wh * 64 + i])); }
    bnd[wh] = 8.f * LOG2E * 1.01f * gq * gk;
  }
  for (;;) {
    int u = next_unit(ctr, lds);
    if (u >= 1536) break;
    if (u < 512) {
      const int qi = 31 - (u >> 4), b = (u >> 2) & 3, hd = u & 3;
      const size_t sl0 = (size_t)((b * 4 + hd) * 2) * S, slv = (size_t)(b * 4 + hd) * S;
      const float slope2 = exp2f(-2.f * (float)(hd + 1)) * LOG2E;
      attn_unit<3>(hb + O_QD + sl0 * 64, hb + O_KD + sl0 * 64, hb + O_VD + slv * 128, hb + O_QD + (sl0 + S) * 64, hb + O_KD + (sl0 + S) * 64, qi, slope2,
                   0.f, lam, 1.f - lambda_init, p.in[22] + j * 128, mix + ((size_t)b * S + qi * 256) * DM + 512 + hd * 128,
                   (float*)(p.ws + WS_STASH) + (size_t)blockIdx.x * 32768, lds, bnd[0], bnd[1]);
    } else {
      u -= 512;
      const int qi = 31 - (u >> 5), b = (u >> 3) & 3, hd = u & 7;
      const size_t sl = (size_t)(b * 8 + hd) * S;
      attn_unit<2>(hb + O_QC + sl * 64, hb + O_KC + sl * 64, hb + O_VC + sl * 64, nullptr, nullptr, qi, 0.f, 0.f, 0.f, 0.f, nullptr,
                   mix + ((size_t)b * S + qi * 256) * DM + hd * 64, nullptr, lds);
    }
  }
}

#define XB_TMO      128
#define XB_XCNT(j)  (256  + 64 * (j))
#define XB_XSUB(j)  (1280 + 64 * (j))
#define XB_XGEN(j)  (2304 + 64 * (j))
#define XB_TOP      3328
#define XB_TOPGEN   3392
#define XCD_BAR_WORDS 3456
#define XB_SPIN_CAP (1u << 22)
DI unsigned xb_ld(unsigned* p) { return __hip_atomic_load(p, __ATOMIC_RELAXED, __HIP_MEMORY_SCOPE_AGENT); }
DI unsigned xb_add(unsigned* p, unsigned v) { return __hip_atomic_fetch_add(p, v, __ATOMIC_RELAXED, __HIP_MEMORY_SCOPE_AGENT); }
DI unsigned xb_xcc_id() { return (unsigned)__builtin_amdgcn_s_getreg((3 << 11) | 20) & 0xFu; }
#define XB_SPIN(cond, bar) do { unsigned _sp = 0; while (cond) { __builtin_amdgcn_s_sleep(1); \
    if ((++_sp & 255u) == 0u) { if (xb_ld(&(bar)[XB_TMO])) break; if (_sp > XB_SPIN_CAP) { atomicAdd(&(bar)[XB_TMO], 1u); break; } } } } while (0)
struct XcdBarrier { unsigned* bar; unsigned x; volatile LDS_AS unsigned* st; };
DI XcdBarrier xcd_barrier_post(unsigned* bar, volatile LDS_AS unsigned* st) {
  XcdBarrier b; b.bar = bar; b.x = xb_xcc_id(); b.st = st;
  if (threadIdx.x == 0) (void)xb_add(&bar[XB_XCNT(b.x)], 1u);
  return b;
}
DI void xcd_barrier_complete(unsigned* bar, unsigned x, unsigned& nloc, unsigned& nx) {
  const unsigned G = gridDim.x * gridDim.y * gridDim.z;
  unsigned sum, cnt, mine, sp = 0u;
  for (;;) {
    sum = 0u; cnt = 0u; mine = 0u;
#pragma unroll
    for (unsigned j = 0; j < 16; ++j) { const unsigned c = xb_ld(&bar[XB_XCNT(j)]); sum += c; cnt += (c > 0u) ? 1u : 0u; mine = (j == x) ? c : mine; }
    if (sum == G) break;
    __builtin_amdgcn_s_sleep(1);
    if ((++sp & 255u) == 0u) { if (xb_ld(&bar[XB_TMO])) break; if (sp > XB_SPIN_CAP) { atomicAdd(&bar[XB_TMO], 1u); break; } }
  }
  nloc = mine > 0u ? mine : 1u; nx = cnt > 0u ? cnt : 1u;
}
DI void xcd_barrier(const XcdBarrier& b) {
  asm volatile("s_waitcnt vmcnt(0)" ::: "memory");
  __syncthreads();
  if (threadIdx.x == 0) {
    unsigned* bar = b.bar;
    __builtin_amdgcn_s_waitcnt(0);
    unsigned nloc = b.st[0], nx = b.st[1];
    if (nloc == 0u) { xcd_barrier_complete(bar, b.x, nloc, nx); b.st[0] = nloc; b.st[1] = nx; }
    const unsigned old = xb_add(&bar[XB_XSUB(b.x)], 1u);
    const unsigned gen = old / nloc;
    if (old + 1u == (gen + 1u) * nloc) {
      __builtin_amdgcn_fence(__ATOMIC_RELEASE, "agent");
      asm volatile("s_waitcnt vmcnt(0)" ::: "memory");
      const unsigned og = xb_add(&bar[XB_TOP], 1u);
      const unsigned tg = og / nx;
      if (og + 1u == (tg + 1u) * nx) xb_add(&bar[XB_TOPGEN], 1u);
      else XB_SPIN(xb_ld(&bar[XB_TOPGEN]) == tg, bar);
      __builtin_amdgcn_fence(__ATOMIC_ACQUIRE, "agent");
      xb_add(&bar[XB_XGEN(b.x)], 1u);
      asm volatile("s_waitcnt vmcnt(0)" ::: "memory");
    } else {
      XB_SPIN(xb_ld(&bar[XB_XGEN(b.x)]) == gen, bar);
      __builtin_amdgcn_fence(__ATOMIC_ACQUIRE, "agent");
      asm volatile("s_waitcnt vmcnt(0)" ::: "memory");
    }
  }
  __syncthreads();
}

enum { K_PRO = 0, K_IN_E, K_UP_E, K_ATT_E, K_IN_O, K_ATT_O, K_OUT, K_MLPUP, K_DOWN };

extern "C" __global__ void __launch_bounds__(512) fwd_kernel(Params p, int ph_lo, int ph_hi) {
  extern __shared__ __attribute__((aligned(16))) unsigned char lds[];
  cg::grid_group grid = cg::this_grid();
  volatile LDS_AS unsigned* xst = (volatile LDS_AS unsigned*)(lds + LDS_TILE_BYTES + 96);
  if (threadIdx.x == 0) { xst[0] = 0u; xst[1] = 0u; }
  __syncthreads();
  XcdBarrier gbar = xcd_barrier_post((unsigned*)(p.ws + WS_BAR), xst);
  unsigned char* wb = p.ws + WS_W;
  bf16_t* xb = (bf16_t*)(p.ws + WS_XB);
  bf16_t* mix = (bf16_t*)(p.ws + WS_MIX);
  bf16_t* hb = (bf16_t*)(p.ws + WS_HID);
  int* ctr = (int*)(p.ws + WS_CTR);
  const int* pos = (const int*)p.in[1];
  for (int ph = ph_lo; ph < ph_hi; ++ph) {
    int kind = K_PRO, L = 0;
    if (ph > 0) {
      const int q = ph - 1, pair = q / 11, rr = q - pair * 11;
      if (rr < 6) { L = 2 * pair; kind = rr == 0 ? K_IN_E : rr == 1 ? K_UP_E : rr == 2 ? K_ATT_E : rr == 3 ? K_OUT : rr == 4 ? K_MLPUP : K_DOWN; }
      else { L = 2 * pair + 1; kind = rr == 6 ? K_IN_O : rr == 7 ? K_ATT_O : rr == 8 ? K_OUT : rr == 9 ? K_MLPUP : K_DOWN; }
    }
    const int j = L >> 1;
    for (int rep = 0; rep < ((kind == PROBE_KIND) ? 2 : 1); ++rep) {
    if (kind == K_PRO) {
      prologue(p, lds);
    } else if (kind == K_IN_E) {
      EpiEvenIn e{hb, p.in[8] + j * 64, p.in[9] + j * 64, p.in[12] + j * 128, lds};
      gemm_phase<true>(xb, 1024, (const bf16_t*)(wb + W_IN_E) + (size_t)j * 1280 * 1024, 1024, 5, e, lds);
    } else if (kind == K_UP_E) {
      EpiUQ e1{hb + E_QB, p.in[15] + j * 96, pos};
      gemm_phase<true>(hb + E_CQ, 256, (const bf16_t*)(wb + W_UQ) + (size_t)j * 1024 * 256, 256, 4, e1, lds);
      EpiUKV e2{hb + E_KB, hb + E_VB, (const float*)(hb + E_KR), p.in[16] + j * 96, pos};
      gemm_phase<false>(hb + E_CKV, 128, (const bf16_t*)(wb + W_UKV) + (size_t)j * 1024 * 128, 128, 4, e2, lds);
    } else if (kind == K_ATT_E) {
      attn_even(p, j, ctr + L + 4 * rep, lds);
    } else if (kind == K_IN_O) {
      EpiOddIn e{hb, p.in[19] + j * 128, p.in[20] + j * 128, lds};
      gemm_phase<true>(xb, 1024, (const bf16_t*)(wb + W_IN_O) + (size_t)j * 3072 * 1024, 1024, 12, e, lds);
    } else if (kind == K_ATT_O) {
      attn_odd(p, j, ctr + L + 4 * rep, lds);
    } else if (kind == K_OUT || kind == K_DOWN) {
      const bool isout = kind == K_OUT;
      EpiResid e{(isout && L == 0) ? p.in[0] : nullptr, xb, (!isout && L == 3) ? p.out : nullptr, lds};
      const bf16_t* Bt = isout ? ((L & 1) ? (const bf16_t*)(wb + W_OUT_O) : (const bf16_t*)(wb + W_OUT_E)) + (size_t)j * 1024 * 1024
                               : (const bf16_t*)(wb + W_DN) + (size_t)L * 1024 * 4096;
      gemm_phase<false>(isout ? mix : hb, isout ? 1024 : 4096, Bt, isout ? 1024 : 4096, 4, e, lds);
    } else {
      EpiRelu2 e{hb, lds};
      gemm_phase<true>(xb, 1024, (const bf16_t*)(wb + W_UP) + (size_t)L * 4096 * 1024, 1024, 16, e, lds);
    }
    if (PROBE_KIND >= 0) __syncthreads();
    }
    if (ph + 1 < ph_hi) {
      if (ph == ph_lo) grid.sync();
      else xcd_barrier(gbar);
    }
  }
}

extern "C" void kernel_launch(void* const* d_in, const int* in_sizes, int n_in, void* d_out, int out_size, void* d_ws, size_t ws_size,
                              hipStream_t stream) {
  static int grid_blocks = 0;
  if (grid_blocks == 0) {
    if (n_in != 23 || out_size != T * DM || ws_size < WS_END) {
      fprintf(stderr, "kernel_launch: unexpected shapes (n_in %d out %d ws %zu need %zu)\n", n_in, out_size, ws_size, (size_t)WS_END);
      grid_blocks = -1;
      return;
    }
    int dev = 0, cus = 0, per_cu = 0;
    hipGetDevice(&dev);
    hipDeviceGetAttribute(&cus, hipDeviceAttributeMultiprocessorCount, dev);
    if (hipFuncSetAttribute((const void*)fwd_kernel, hipFuncAttributeMaxDynamicSharedMemorySize, LDS_BYTES) != hipSuccess)
      fprintf(stderr, "kernel_launch: hipFuncSetAttribute failed\n");
    hipOccupancyMaxActiveBlocksPerMultiprocessor(&per_cu, (const void*)fwd_kernel, NT, LDS_BYTES);
    if (per_cu > 1) per_cu = 1;
    if (per_cu < 1) { fprintf(stderr, "kernel_launch: occupancy query gave %d\n", per_cu); per_cu = 1; }
    grid_blocks = cus * per_cu;
  }
  if (grid_blocks < 0) return;
  Params p{};
  for (int i = 0; i < 23; ++i) p.in[i] = (const float*)d_in[i];
  p.out = (float*)d_out;
  p.ws = (unsigned char*)d_ws;
  if (hipMemsetAsync((char*)d_ws + WS_BAR, 0, 16384, stream) != hipSuccess) fprintf(stderr, "kernel_launch: memset of barrier words failed\n");
#if MULTI_LAUNCH
  for (int ph = 0; ph < NPHASE; ++ph) hipLaunchKernelGGL(fwd_kernel, dim3(grid_blocks), dim3(NT), LDS_BYTES, stream, p, ph, ph + 1);
#else
  int lo = 0, hi = NPHASE;
  void* args[] = {&p, &lo, &hi};
  hipError_t e = hipLaunchCooperativeKernel((const void*)fwd_kernel, dim3(grid_blocks), dim3(NT), args, LDS_BYTES, stream);
  if (e != hipSuccess) fprintf(stderr, "cooperative launch failed: %s (grid %d)\n", hipGetErrorString(e), grid_blocks);
#endif
}
```

```cpp
#include <hip/hip_runtime.h>
#include <hip/hip_cooperative_groups.h>
#include <cstdio>
#include <cstdint>
namespace cg = cooperative_groups;

#ifndef PROBE_KIND
#define PROBE_KIND -1
#endif
#ifndef MULTI_LAUNCH
#define MULTI_LAUNCH 0
#endif

typedef unsigned short bf16_t;
typedef short bf16x8 __attribute__((ext_vector_type(8)));
typedef short s16x4 __attribute__((ext_vector_type(4)));
typedef float f32x16 __attribute__((ext_vector_type(16)));
typedef float f32x4 __attribute__((ext_vector_type(4)));
typedef float f32x2 __attribute__((ext_vector_type(2)));
typedef __bf16 bf16x2_t __attribute__((ext_vector_type(2)));
typedef unsigned u32x2 __attribute__((ext_vector_type(2)));
typedef unsigned u32x4 __attribute__((ext_vector_type(4)));
#define DI __device__ __forceinline__
#define LDS_AS __attribute__((address_space(3)))

constexpr int T = 32768, S = 8192, DM = 1024, DFF = 4096;
constexpr float EPS = 1e-6f;
constexpr float LOG2E = 1.4426950408889634f;
constexpr int NPHASE = 23;
constexpr int NT = 512;
constexpr int LDS_TILE_BYTES = 147456;
constexpr int LDS_BYTES = LDS_TILE_BYTES + 128;

constexpr size_t MiB = 1024 * 1024;
constexpr size_t WS_XB = 0;
constexpr size_t WS_MIX = 64 * MiB;
constexpr size_t WS_HID = 128 * MiB;
constexpr size_t WS_W = 384 * MiB;
constexpr size_t W_IN_E = 0;
constexpr size_t W_UQ = W_IN_E + 2ull * 1280 * 1024 * 2;
constexpr size_t W_UKV = W_UQ + 2ull * 1024 * 256 * 2;
constexpr size_t W_OUT_E = W_UKV + 2ull * 1024 * 128 * 2;
constexpr size_t W_IN_O = W_OUT_E + 2ull * 1024 * 1024 * 2;
constexpr size_t W_OUT_O = W_IN_O + 2ull * 3072 * 1024 * 2;
constexpr size_t W_UP = W_OUT_O + 2ull * 1024 * 1024 * 2;
constexpr size_t W_DN = W_UP + 4ull * 4096 * 1024 * 2;
constexpr size_t W_END = W_DN + 4ull * 4096 * 1024 * 2;
constexpr size_t WS_CTR = WS_W + W_END;
constexpr size_t WS_BAR = WS_CTR + 256;
constexpr size_t WS_STASH = WS_BAR + 16384;
constexpr size_t WS_END = WS_STASH + 256ull * 131072;
constexpr size_t TE = (size_t)T;
constexpr size_t E_QA = 0, E_KA = E_QA + TE * 512, E_VA = E_KA + TE * 128, E_CQ = E_VA + TE * 128, E_CKV = E_CQ + TE * 256,
                 E_QB = E_CKV + TE * 128, E_KB = E_QB + TE * 768, E_VB = E_KB + TE * 768, E_KR = E_VB + TE * 512  ;
constexpr size_t O_QC = 0, O_KC = TE * 512, O_VC = TE * 1024, O_QD = TE * 1536, O_KD = TE * 2048, O_VD = TE * 2560;

struct Params {
  const float* in[23];
  float* out;
  unsigned char* ws;
};

DI unsigned pack2(float lo, float hi) {
  f32x2 f = {lo, hi};
  bf16x2_t b = __builtin_convertvector(f, bf16x2_t);
  return __builtin_bit_cast(unsigned, b);
}
DI void st4(bf16_t* p, float a, float b, float c, float d) {
  u32x2 v = {pack2(a, b), pack2(c, d)};
  *(u32x2*)p = v;
}
DI bf16x8 pack8(const f32x16& x, int o) {
  u32x4 v = {pack2(x[o], x[o + 1]), pack2(x[o + 2], x[o + 3]), pack2(x[o + 4], x[o + 5]), pack2(x[o + 6], x[o + 7])};
  return __builtin_bit_cast(bf16x8, v);
}
DI float ex2(float x) { return __builtin_amdgcn_exp2f(x); }
DI float lg2(float x) { return __builtin_amdgcn_logf(x); }
DI float xor32(float x) { return __shfl_xor(x, 32); }
#define MFMA(a, b, c) __builtin_amdgcn_mfma_f32_32x32x16_bf16((a), (b), (c), 0, 0, 0)
DI int opaque_tid() { int t = threadIdx.x; asm volatile("" : "+v"(t)); return t; }
DI f32x16 zero16() { f32x16 z; for (int i = 0; i < 16; ++i) z[i] = 0.f; return z; }

DI void tconv(const float* __restrict__ src, const float* __restrict__ gain, int N, int K, bf16_t* __restrict__ dst, int Npad, int grp,
              int grp_pad, unsigned char* lds) {
  const int tid5 = opaque_tid();
  const int half = tid5 >> 8, tid = tid5 & 255;
  float* tile = (float*)lds + half * (64 * 33);
  const int nkt = K >> 6, ntl = (Npad >> 5) * nkt;
  for (int tt = blockIdx.x; 2 * tt < ntl; tt += gridDim.x) {
    const int t = 2 * tt + half;
    const bool active = t < ntl;
    const int ntile = t / nkt, kt = t - ntile * nkt;
    const int np0 = ntile * 32, k0 = kt * 64;
    const int gi = np0 / grp_pad, go = np0 - gi * grp_pad;
    const int sn0 = gi * grp + go;
    const bool valid = active && (go < grp) && (sn0 < N);
    if (valid) {
#pragma unroll
      for (int p = 0; p < 2; ++p) {
        const int kk = (tid >> 3) + 32 * p, nn = (tid & 7) * 4;
        const f32x4 v = *(const f32x4*)(src + (size_t)(k0 + kk) * N + sn0 + nn);
        const float gsc = gain ? gain[k0 + kk] : 1.f;
#pragma unroll
        for (int e = 0; e < 4; ++e) tile[kk * 33 + nn + e] = v[e] * gsc;
      }
    }
    __syncthreads();
    if (active) {
      const int n = tid >> 3, kq = (tid & 7) * 8;
      u32x4 o = {0u, 0u, 0u, 0u};
      if (valid) {
        float f[8];
#pragma unroll
        for (int j = 0; j < 8; ++j) f[j] = tile[(kq + j) * 33 + n];
        o[0] = pack2(f[0], f[1]); o[1] = pack2(f[2], f[3]); o[2] = pack2(f[4], f[5]); o[3] = pack2(f[6], f[7]);
      }
      *(u32x4*)(dst + (size_t)(np0 + n) * K + k0 + kq) = o;
    }
    __syncthreads();
  }
}

DI void prologue(const Params& p, unsigned char* lds) {
  unsigned char* wb = p.ws + WS_W;
  if (blockIdx.x == 0 && threadIdx.x < 64) ((int*)(p.ws + WS_CTR))[threadIdx.x] = 0;
  {
    const float* x = p.in[0];
    bf16_t* xb = (bf16_t*)(p.ws + WS_XB);
    const size_t n8 = (size_t)T * DM / 8;
    for (size_t i = (size_t)blockIdx.x * NT + threadIdx.x; i < n8; i += (size_t)gridDim.x * NT) {
      const f32x4 a = *(const f32x4*)(x + i * 8), b = *(const f32x4*)(x + i * 8 + 4);
      u32x4 o = {pack2(a[0], a[1]), pack2(a[2], a[3]), pack2(b[0], b[1]), pack2(b[2], b[3])};
      *(u32x4*)(xb + i * 8) = o;
    }
  }
  for (int j = 0; j < 2; ++j) {
    tconv(p.in[6] + (size_t)j * 1024 * 1184, p.in[2] + (2 * j) * 1024, 1184, 1024, (bf16_t*)(wb + W_IN_E) + (size_t)j * 1280 * 1024, 1280, 1280, 1280, lds);
    tconv(p.in[13] + (size_t)j * 256 * 768, p.in[11] + j * 256, 768, 256, (bf16_t*)(wb + W_UQ) + (size_t)j * 1024 * 256, 1024, 96, 128, lds);
    tconv(p.in[14] + (size_t)j * 128 * 1024, nullptr, 1024, 128, (bf16_t*)(wb + W_UKV) + (size_t)j * 1024 * 128, 1024, 1024, 1024, lds);
    tconv(p.in[7] + (size_t)j * 1024 * 1024, nullptr, 1024, 1024, (bf16_t*)(wb + W_OUT_E) + (size_t)j * 1024 * 1024, 1024, 1024, 1024, lds);
    tconv(p.in[17] + (size_t)j * 1024 * 3072, p.in[2] + (2 * j + 1) * 1024, 3072, 1024, (bf16_t*)(wb + W_IN_O) + (size_t)j * 3072 * 1024, 3072, 3072, 3072, lds);
    tconv(p.in[18] + (size_t)j * 1024 * 1024, nullptr, 1024, 1024, (bf16_t*)(wb + W_OUT_O) + (size_t)j * 1024 * 1024, 1024, 1024, 1024, lds);
  }
  for (int L = 0; L < 4; ++L) {
    tconv(p.in[4] + (size_t)L * 1024 * 4096, p.in[3] + L * 1024, 4096, 1024, (bf16_t*)(wb + W_UP) + (size_t)L * 4096 * 1024, 4096, 4096, 4096, lds);
    tconv(p.in[5] + (size_t)L * 4096 * 1024, nullptr, 1024, 4096, (bf16_t*)(wb + W_DN) + (size_t)L * 1024 * 4096, 1024, 1024, 1024, lds);
  }
}

constexpr int G_OP = 256 * 64;
constexpr int G_STAGE = 2 * G_OP;
constexpr int G_NST = 4;
static_assert(G_NST * G_STAGE <= LDS_TILE_BYTES, "LDS ring");

DI void tile_map(int t, int Ntiles, int& mt, int& nt) {
  const int xcd = t & 7, j = t >> 3;
  const int per = 4 * Ntiles;
  const int g = j / per, r = j - g * per;
  nt = r >> 2;
  mt = (g * 4 + (r & 3)) * 8 + xcd;
}

template <bool ROWSS>
DI void frag_ss(const bf16x8& af, float& ss) {
  if (ROWSS) {
    typedef __bf16 bf2 __attribute__((ext_vector_type(2)));
    typedef __bf16 bf8 __attribute__((ext_vector_type(8)));
    const bf8 v = __builtin_bit_cast(bf8, af);
#pragma unroll
    for (int e = 0; e < 4; ++e) {
      const bf2 t = {v[2 * e], v[2 * e + 1]};
      ss = __builtin_amdgcn_fdot2_f32_bf16(t, t, ss, false);
    }
  }
}

DI void lds_barrier() {
  __builtin_amdgcn_s_waitcnt(0xC07F);
  __builtin_amdgcn_s_barrier();
  asm volatile("" ::: "memory");
}

template <bool ROWSS, class Epi>
DI void gemm_phase(const bf16_t* A, int lda, const bf16_t* Bt, int K, int Ntiles, const Epi& epi, unsigned char* lds) {
  const int tid = opaque_tid(), lane = tid & 63, w = tid >> 6, h = lane >> 5, r = lane & 31;
  const int wm = w & 3, wn = w >> 2;
  const int ntiles = (T / 256) * Ntiles;
  const int nk = K >> 5;
  const int fsw = (h ^ ((r >> 2) & 3)) * 16;
  const int a_off = (64 * wm + r) * 64 + fsw;
  const int b_off = G_OP + (128 * wn + r) * 64 + fsw;
  const int grow = lane >> 2, gch = ((lane & 3) ^ ((lane >> 4) & 3)) * 8;
  const int wu = __builtin_amdgcn_readfirstlane(w);
  int t = blockIdx.x;
  int m0 = 0, nt = 0;
  const bf16_t* ag = A;
  const bf16_t* bg = Bt;
  auto set_tile = [&](int tt) {
    int mt_;
    tile_map(tt, Ntiles, mt_, nt);
    m0 = mt_ * 256;
    ag = A + (size_t)(m0 + 16 * w + grow) * lda + gch;
    bg = Bt + (size_t)(nt * 256 + 16 * w + grow) * K + gch;
  };
  bool primed = false;
  while (t < ntiles) {
    auto glds1 = [&](int kt, int piece) {
      unsigned char* st = lds + (kt & (G_NST - 1)) * G_STAGE + wu * 1024;
      const int k0 = kt * 32;
      if (piece == 0) __builtin_amdgcn_global_load_lds((const unsigned*)(ag + k0), (unsigned*)(st), 16, 0, 0);
      if (piece == 1) __builtin_amdgcn_global_load_lds((const unsigned*)(ag + (size_t)128 * lda + k0), (unsigned*)(st + 8192), 16, 0, 0);
      if (piece == 2) __builtin_amdgcn_global_load_lds((const unsigned*)(bg + k0), (unsigned*)(st + G_OP), 16, 0, 0);
      if (piece == 3) __builtin_amdgcn_global_load_lds((const unsigned*)(bg + (size_t)128 * K + k0), (unsigned*)(st + G_OP + 8192), 16, 0, 0);
    };
    auto glds = [&](int kt) { glds1(kt, 0); glds1(kt, 1); glds1(kt, 2); glds1(kt, 3); };
    if (!primed) {
      set_tile(t);
      asm volatile("s_waitcnt vmcnt(0)" ::: "memory");
      glds(0); glds(1); glds(2);
      primed = true;
    }
    f32x16 acc[2][4];
#pragma unroll
    for (int mb = 0; mb < 2; ++mb)
#pragma unroll
      for (int nb = 0; nb < 4; ++nb) acc[mb][nb] = zero16();
    float ss0 = 0.f, ss1 = 0.f;
    bf16x8 af0[2], wf0[4], af1[2], wf1[4];
    for (int kt = 0; kt < nk; ++kt) {
      if (kt + 2 < nk) asm volatile("s_waitcnt vmcnt(4)" ::: "memory"); else asm volatile("s_waitcnt vmcnt(0)" ::: "memory");
      lds_barrier();
      const bool pf = kt + 3 < nk;
      const unsigned char* sc = lds + (kt & (G_NST - 1)) * G_STAGE;
      if (kt == 0) {
#pragma unroll
        for (int mb = 0; mb < 2; ++mb) af0[mb] = *(const bf16x8*)(sc + a_off + 2048 * mb);
#pragma unroll
        for (int nb = 0; nb < 4; ++nb) wf0[nb] = *(const bf16x8*)(sc + b_off + 2048 * nb);
      }
#pragma unroll
      for (int mb = 0; mb < 2; ++mb) af1[mb] = *(const bf16x8*)(sc + (a_off ^ 32) + 2048 * mb);
#pragma unroll
      for (int nb = 0; nb < 4; ++nb) wf1[nb] = *(const bf16x8*)(sc + (b_off ^ 32) + 2048 * nb);
      __builtin_amdgcn_sched_barrier(0);
      frag_ss<ROWSS>(af0[0], ss0);
      frag_ss<ROWSS>(af0[1], ss1);
#pragma unroll
      for (int nb = 0; nb < 4; ++nb) {
#pragma unroll
        for (int mb = 0; mb < 2; ++mb) acc[mb][nb] = MFMA(wf0[nb], af0[mb], acc[mb][nb]);
        if (nb == 1) { __builtin_amdgcn_sched_barrier(0); if (pf) glds1(kt + 3, 0); __builtin_amdgcn_sched_barrier(0); }
        if (nb == 3) { __builtin_amdgcn_sched_barrier(0); if (pf) glds1(kt + 3, 1); }
      }
      __builtin_amdgcn_sched_barrier(0);
      __builtin_amdgcn_sched_barrier(0);
      frag_ss<ROWSS>(af1[0], ss0);
      frag_ss<ROWSS>(af1[1], ss1);
#pragma unroll
      for (int nb = 0; nb < 4; ++nb) {
#pragma unroll
        for (int mb = 0; mb < 2; ++mb) acc[mb][nb] = MFMA(wf1[nb], af1[mb], acc[mb][nb]);
        if (nb == 0) {
          __builtin_amdgcn_sched_barrier(0);
          if (kt + 1 < nk) {
            const unsigned char* sn = lds + ((kt + 1) & (G_NST - 1)) * G_STAGE;
#pragma unroll
            for (int mb = 0; mb < 2; ++mb) af0[mb] = *(const bf16x8*)(sn + a_off + 2048 * mb);
#pragma unroll
            for (int nb2 = 0; nb2 < 4; ++nb2) wf0[nb2] = *(const bf16x8*)(sn + b_off + 2048 * nb2);
          }
          __builtin_amdgcn_sched_barrier(0);
        }
        if (nb == 1) { __builtin_amdgcn_sched_barrier(0); if (pf) glds1(kt + 3, 2); __builtin_amdgcn_sched_barrier(0); }
        if (nb == 3) { __builtin_amdgcn_sched_barrier(0); if (pf) glds1(kt + 3, 3); }
      }
      __builtin_amdgcn_sched_barrier(0);
    }
    lds_barrier();
    float rs0 = 1.f, rs1 = 1.f;
    if (ROWSS) {
      ss0 += xor32(ss0);
      ss1 += xor32(ss1);
      rs0 = rsqrtf(ss0 / (float)K + EPS);
      rs1 = rsqrtf(ss1 / (float)K + EPS);
    }
    const int mrow = m0 + 64 * wm + r, nt128 = 2 * nt + wn;
    t += gridDim.x;
    if (t < ntiles) { set_tile(t); glds(0); glds(1); glds(2); }
    epi(acc[0], mrow, nt128, h, rs0);
    epi(acc[1], mrow + 32, nt128, h, rs1);
  }
}

DI void swap8(const f32x16& a, int p, float (&v)[8]) {
#pragma unroll
  for (int e = 0; e < 4; ++e) {
    const auto r = __builtin_amdgcn_permlane32_swap(__float_as_uint(a[8 * p + e]), __float_as_uint(a[8 * p + 4 + e]), false, false);
    v[e] = __uint_as_float(r[0]);
    v[4 + e] = __uint_as_float(r[1]);
  }
}
DI u32x4 pk8(const float (&v)[8], float r, const float* gain) {
  float o[8];
  if (gain) {
    const f32x4 g0 = *(const f32x4*)(gain), g1 = *(const f32x4*)(gain + 4);
#pragma unroll
    for (int e = 0; e < 4; ++e) { o[e] = v[e] * r * g0[e]; o[4 + e] = v[4 + e] * r * g1[e]; }
  } else {
#pragma unroll
    for (int e = 0; e < 8; ++e) o[e] = v[e] * r;
  }
  return (u32x4){pack2(o[0], o[1]), pack2(o[2], o[3]), pack2(o[4], o[5]), pack2(o[6], o[7])};
}
DI void st8(bf16_t* p, const float (&v)[8], float r, const float* gain) {
  float o[8];
  if (gain) {
    const f32x4 g0 = *(const f32x4*)(gain), g1 = *(const f32x4*)(gain + 4);
#pragma unroll
    for (int e = 0; e < 4; ++e) { o[e] = v[e] * r * g0[e]; o[4 + e] = v[4 + e] * r * g1[e]; }
  } else {
#pragma unroll
    for (int e = 0; e < 8; ++e) o[e] = v[e] * r;
  }
  u32x4 u = {pack2(o[0], o[1]), pack2(o[2], o[3]), pack2(o[4], o[5]), pack2(o[6], o[7])};
  *(u32x4*)p = u;
}
constexpr int EPI_LDS = 3 * G_STAGE;
DI void stage_put(unsigned char* reg, int r, int chunk, const u32x4& o) { *(u32x4*)(reg + r * 128 + ((chunk ^ (r & 7)) << 4)) = o; }
DI void stage_flush(unsigned char* reg, bf16_t* dst0, size_t ld) {
  const int lane = opaque_tid() & 63;
  __builtin_amdgcn_s_waitcnt(0xC07F);
#pragma unroll
  for (int q = 0; q < 4; ++q) {
    const int row = 8 * q + (lane >> 3), phys = lane & 7;
    const u32x4 v = *(const u32x4*)(reg + row * 128 + (phys << 4));
    *(u32x4*)(dst0 + (size_t)row * ld + ((phys ^ (row & 7)) << 3)) = v;
  }
  __builtin_amdgcn_s_waitcnt(0xC07F);
  __builtin_amdgcn_sched_barrier(0);
}
struct EpiResid {
  const float* res_f32; bf16_t* xb; float* out_f32; unsigned char* lds;
  DI void operator()(f32x16 (&acc)[4], int m, int nt, int h, float) const {
    const size_t base = (size_t)m * DM + nt * 128;
    const int r = m & 31;
    unsigned char* reg = lds + EPI_LDS + (opaque_tid() >> 6) * 4096;
#pragma unroll
    for (int nb = 0; nb < 4; ++nb) {
#pragma unroll
      for (int p = 0; p < 2; ++p) {
        const int c = 32 * nb + 8 * (2 * p + h);
        float v[8];
        swap8(acc[nb], p, v);
        if (res_f32) {
          const f32x4 r0 = *(const f32x4*)(res_f32 + base + c), r1 = *(const f32x4*)(res_f32 + base + c + 4);
#pragma unroll
          for (int e = 0; e < 4; ++e) { v[e] += r0[e]; v[4 + e] += r1[e]; }
        } else {
          const u32x4 u = *(const u32x4*)(xb + base + c);
#pragma unroll
          for (int e = 0; e < 4; ++e) { v[2 * e] += __uint_as_float(u[e] << 16); v[2 * e + 1] += __uint_as_float(u[e] & 0xffff0000u); }
        }
        if (out_f32) {
          *(f32x4*)(out_f32 + base + c) = (f32x4){v[0], v[1], v[2], v[3]};
          *(f32x4*)(out_f32 + base + c + 4) = (f32x4){v[4], v[5], v[6], v[7]};
        } else {
          const u32x4 o = {pack2(v[0], v[1]), pack2(v[2], v[3]), pack2(v[4], v[5]), pack2(v[6], v[7])};
          stage_put(reg, r, 4 * (nb & 1) + 2 * p + h, o);
        }
      }
      if (!out_f32 && (nb & 1)) stage_flush(reg, xb + (size_t)(m - r) * DM + nt * 128 + 64 * (nb >> 1), DM);
    }
  }
};
struct EpiRelu2 {
  bf16_t* hid; unsigned char* lds;
  DI void operator()(f32x16 (&acc)[4], int m, int nt, int h, float rs) const {
    const int r = m & 31;
    unsigned char* reg = lds + EPI_LDS + (opaque_tid() >> 6) * 4096;
    bf16_t* blk = hid + (size_t)(m - r) * DFF + nt * 128;
#pragma unroll
    for (int ch = 0; ch < 2; ++ch) {
#pragma unroll
      for (int nb2 = 0; nb2 < 2; ++nb2)
#pragma unroll
        for (int p = 0; p < 2; ++p) {
          float v[8];
          swap8(acc[2 * ch + nb2], p, v);
#pragma unroll
          for (int e = 0; e < 8; ++e) { const float a = fmaxf(v[e] * rs, 0.f); v[e] = a * a; }
          const u32x4 o = {pack2(v[0], v[1]), pack2(v[2], v[3]), pack2(v[4], v[5]), pack2(v[6], v[7])};
          stage_put(reg, r, 4 * nb2 + 2 * p + h, o);
        }
      stage_flush(reg, blk + 64 * ch, DFF);
    }
  }
};
constexpr float QS_64 = 0.125f * LOG2E;
constexpr float QS_96 = 0.10206207261596575f * LOG2E;

struct EpiEvenIn {
  bf16_t* hb; const float *a_qg, *a_kg, *b_ckvg; unsigned char* lds;
  DI void operator()(f32x16 (&acc)[4], int m, int nt, int h, float rs) const {
    const int b = m >> 13, s = m & (S - 1);
    unsigned char* sreg = lds + EPI_LDS + (opaque_tid() >> 6) * 4096;
    if (nt < 6) {
#pragma unroll
      for (int hh = 0; hh < 2; ++hh) {
        float r = rs;
        const float* gain = nullptr;
        bf16_t* dst;
        if (nt < 5) {
          float ss = 0.f;
#pragma unroll
          for (int x = 0; x < 2; ++x)
#pragma unroll
            for (int i = 0; i < 16; ++i) { const float v = acc[2 * hh + x][i] * rs; ss = fmaf(v, v, ss); }
          ss += xor32(ss);
          r = rsqrtf(ss * (1.f / 64.f) + EPS) * rs;
          if (nt < 4) { gain = a_qg; r *= QS_64; } else gain = a_kg;
        }
        {
          const size_t off = (nt < 4) ? E_QA + ((size_t)(b * 8 + 2 * nt + hh) * S + s) * 64
                                      : E_KA + (size_t)(nt - 4) * (TE * 128) + ((size_t)(b * 2 + hh) * S + s) * 64;
          dst = hb + off;
        }
#pragma unroll
        for (int x = 0; x < 2; ++x)
#pragma unroll
          for (int pq = 0; pq < 2; ++pq) {
            const int d = 32 * x + 8 * (2 * pq + h);
            float v[8];
            swap8(acc[2 * hh + x], pq, v);
            stage_put(sreg, m & 31, 4 * x + 2 * pq + h, pk8(v, r, gain ? gain + d : nullptr));
          }
        stage_flush(sreg, dst - (m & 31) * 64, 64);
      }
    } else if (nt < 8) {
      bf16_t* dst = hb + E_CQ + (size_t)m * 256 + (nt - 6) * 128;
#pragma unroll
      for (int nb = 0; nb < 4; ++nb) {
#pragma unroll
        for (int pq = 0; pq < 2; ++pq) {
          float v[8];
          swap8(acc[nb], pq, v);
          stage_put(sreg, m & 31, 4 * (nb & 1) + 2 * pq + h, pk8(v, rs, nullptr));
        }
        if (nb & 1) stage_flush(sreg, dst - (size_t)(m & 31) * 256 + 64 * (nb >> 1), 256);
      }
    } else if (nt == 8) {
      float ss = 0.f;
#pragma unroll
      for (int nb = 0; nb < 4; ++nb)
#pragma unroll
        for (int i = 0; i < 16; ++i) { const float v = acc[nb][i] * rs; ss = fmaf(v, v, ss); }
      ss += xor32(ss);
      const float r = rsqrtf(ss * (1.f / 128.f) + EPS) * rs;
      bf16_t* dst = hb + E_CKV + (size_t)m * 128;
#pragma unroll
      for (int nb = 0; nb < 4; ++nb) {
#pragma unroll
        for (int pq = 0; pq < 2; ++pq) {
          const int c = 32 * nb + 8 * (2 * pq + h);
          float v[8];
          swap8(acc[nb], pq, v);
          stage_put(sreg, m & 31, 4 * (nb & 1) + 2 * pq + h, pk8(v, r, b_ckvg + c));
        }
        if (nb & 1) stage_flush(sreg, dst - (size_t)(m & 31) * 128 + 64 * (nb >> 1), 128);
      }
    } else {
      float* dst = (float*)(hb + E_KR) + (size_t)m * 32;
#pragma unroll
      for (int g = 0; g < 4; ++g) {
        f32x4 v = {acc[0][4 * g] * rs, acc[0][4 * g + 1] * rs, acc[0][4 * g + 2] * rs, acc[0][4 * g + 3] * rs};
        *(f32x4*)(dst + 8 * g + 4 * h) = v;
      }
    }
  }
};

DI void sincos_cw(float x, float& sn, float& cs) {
  const float k = rintf(x * 0.63661977236758134f);
  float r = fmaf(-k, 1.57079637050628662109375f, x);
  r = fmaf(-k, -4.37113900018624283e-8f, r);
  const int q = (int)k;
  const float r2 = r * r;
  const float sp = fmaf(r * r2, fmaf(r2, fmaf(r2, -1.9515295891e-4f, 8.3321608736e-3f), -1.6666654611e-1f), r);
  const float cp = fmaf(r2 * r2, fmaf(r2, fmaf(r2, 2.443315711809948e-5f, -1.388731625493765e-3f), 4.166664568298827e-2f), fmaf(r2, -0.5f, 1.f));
  const float s0 = (q & 1) ? cp : sp, c0 = (q & 1) ? sp : cp;
  sn = (q & 2) ? -s0 : s0;
  cs = ((q + 1) & 2) ? -c0 : c0;
}
DI constexpr float rope_inv(int i) {
  return i == 0 ? 1.f : i == 1 ? 0.5623413251903491f : i == 2 ? 0.31622776601683794f : i == 3 ? 0.1778279410038923f : i == 4 ? 0.1f
       : i == 5 ? 0.05623413251903491f : i == 6 ? 0.031622776601683794f : i == 7 ? 0.01778279410038923f : i == 8 ? 0.01f
       : i == 9 ? 0.005623413251903491f : i == 10 ? 0.0031622776601683794f : i == 11 ? 0.001778279410038923f : i == 12 ? 0.001f
       : i == 13 ? 0.0005623413251903491f : i == 14 ? 0.00031622776601683794f : 0.0001778279410038923f;
}
DI void rope4(const float (&y1)[4], const float (&y2)[4], int gg, int h, float posf, float (&o1)[4], float (&o2)[4]) {
#pragma unroll
  for (int e = 0; e < 4; ++e) {
    const float inv = h ? rope_inv(8 * gg + 4 + e) : rope_inv(8 * gg + e);
    const float ang = posf * inv;
    float sn, cs;
    sincos_cw(ang, sn, cs);
    o1[e] = y1[e] * cs - y2[e] * sn;
    o2[e] = y1[e] * sn + y2[e] * cs;
  }
}

struct EpiUQ {
  bf16_t* QB; const float* b_qg; const int* pos;
  DI void operator()(f32x16 (&acc)[4], int m, int nt, int h, float rs) const {
    const int b = m >> 13, s = m & (S - 1);
    float ss = 0.f;
#pragma unroll
    for (int nb = 0; nb < 3; ++nb)
#pragma unroll
      for (int i = 0; i < 16; ++i) { const float v = acc[nb][i] * rs; ss = fmaf(v, v, ss); }
    ss += xor32(ss);
    const float r = rsqrtf(ss * (1.f / 96.f) + EPS) * rs * QS_96;
    bf16_t* dst = QB + ((size_t)(b * 8 + nt) * S + s) * 96;
#pragma unroll
    for (int nb = 0; nb < 2; ++nb)
#pragma unroll
      for (int pq = 0; pq < 2; ++pq) {
        const int c = 32 * nb + 8 * (2 * pq + h);
        float v[8];
        swap8(acc[nb], pq, v);
        st8(dst + c, v, r, b_qg + c);
      }
    const float posf = (float)pos[m];
#pragma unroll
    for (int gg = 0; gg < 2; ++gg) {
      const int ri0 = 8 * gg + 4 * h;
      const f32x4 g1 = *(const f32x4*)(b_qg + 64 + ri0), g2 = *(const f32x4*)(b_qg + 80 + ri0);
      float y1[4], y2[4], o1[4], o2[4];
#pragma unroll
      for (int e = 0; e < 4; ++e) { y1[e] = acc[2][4 * gg + e] * r * g1[e]; y2[e] = acc[2][4 * gg + 8 + e] * r * g2[e]; }
      rope4(y1, y2, gg, h, posf, o1, o2);
      st4(dst + 64 + ri0, o1[0], o1[1], o1[2], o1[3]);
      st4(dst + 80 + ri0, o2[0], o2[1], o2[2], o2[3]);
    }
  }
};

struct EpiUKV {
  bf16_t *KB, *VB; const float* KR; const float* b_kg; const int* pos;
  DI void operator()(f32x16 (&acc)[4], int m, int nt, int h, float) const {
    const int b = m >> 13, s = m & (S - 1);
    f32x4 k1[2], k2[2];
    float ss = 0.f;
#pragma unroll
    for (int gg = 0; gg < 2; ++gg) {
      k1[gg] = *(const f32x4*)(KR + (size_t)m * 32 + 8 * gg + 4 * h);
      k2[gg] = *(const f32x4*)(KR + (size_t)m * 32 + 16 + 8 * gg + 4 * h);
#pragma unroll
      for (int e = 0; e < 4; ++e) { ss = fmaf(k1[gg][e], k1[gg][e], ss); ss = fmaf(k2[gg][e], k2[gg][e], ss); }
    }
#pragma unroll
    for (int nb = 0; nb < 2; ++nb)
#pragma unroll
      for (int i = 0; i < 16; ++i) ss = fmaf(acc[nb][i], acc[nb][i], ss);
    ss += xor32(ss);
    const float r = rsqrtf(ss * (1.f / 96.f) + EPS);
    bf16_t* dst = KB + ((size_t)(b * 8 + nt) * S + s) * 96;
#pragma unroll
    for (int nb = 0; nb < 2; ++nb)
#pragma unroll
      for (int pq = 0; pq < 2; ++pq) {
        const int c = 32 * nb + 8 * (2 * pq + h);
        float v[8];
        swap8(acc[nb], pq, v);
        st8(dst + c, v, r, b_kg + c);
      }
    const float posf = (float)pos[m];
#pragma unroll
    for (int gg = 0; gg < 2; ++gg) {
      const int ri0 = 8 * gg + 4 * h;
      const f32x4 g1 = *(const f32x4*)(b_kg + 64 + ri0), g2 = *(const f32x4*)(b_kg + 80 + ri0);
      float y1[4], y2[4], o1[4], o2[4];
#pragma unroll
      for (int e = 0; e < 4; ++e) { y1[e] = k1[gg][e] * r * g1[e]; y2[e] = k2[gg][e] * r * g2[e]; }
      rope4(y1, y2, gg, h, posf, o1, o2);
      st4(dst + 64 + ri0, o1[0], o1[1], o1[2], o1[3]);
      st4(dst + 80 + ri0, o2[0], o2[1], o2[2], o2[3]);
    }
    bf16_t* vd = VB + ((size_t)(b * 8 + nt) * S + s) * 64;
#pragma unroll
    for (int nb = 2; nb < 4; ++nb)
#pragma unroll
      for (int pq = 0; pq < 2; ++pq) {
        float v[8];
        swap8(acc[nb], pq, v);
        st8(vd + 32 * (nb - 2) + 8 * (2 * pq + h), v, 1.f, nullptr);
      }
  }
};

struct EpiOddIn {
  bf16_t* hb; const float *d_qg, *d_kg; unsigned char* lds;
  DI void operator()(f32x16 (&acc)[4], int m, int nt, int h, float rs) const {
    const int b = m >> 13, s = m & (S - 1);
    unsigned char* sreg = lds + EPI_LDS + (opaque_tid() >> 6) * 4096;
    const int region = nt >> 2, r4 = nt & 3;
    if (region < 5) {
#pragma unroll
      for (int hh = 0; hh < 2; ++hh) {
        float r = rs;
        const float* gain = nullptr;
        bf16_t* dst;
        if (region < 3) {
          if (region == 0) r *= QS_64;
          dst = hb + (size_t)region * (TE * 512) + ((size_t)(b * 8 + 2 * r4 + hh) * S + s) * 64;
        } else {
          float ss = 0.f;
#pragma unroll
          for (int x = 0; x < 2; ++x)
#pragma unroll
            for (int i = 0; i < 16; ++i) { const float v = acc[2 * hh + x][i] * rs; ss = fmaf(v, v, ss); }
          ss += xor32(ss);
          r = rsqrtf(ss * (1.f / 64.f) + EPS) * rs;
          if (region == 3) { gain = d_qg + hh * 64; r *= QS_64; } else gain = d_kg + hh * 64;
          dst = hb + (size_t)region * (TE * 512) + ((size_t)((b * 4 + r4) * 2 + hh) * S + s) * 64;
        }
#pragma unroll
        for (int x = 0; x < 2; ++x)
#pragma unroll
          for (int pq = 0; pq < 2; ++pq) {
            const int d = 32 * x + 8 * (2 * pq + h);
            float v[8];
            swap8(acc[2 * hh + x], pq, v);
            stage_put(sreg, m & 31, 4 * x + 2 * pq + h, pk8(v, r, gain ? gain + d : nullptr));
          }
        stage_flush(sreg, dst - (m & 31) * 64, 64);
      }
    } else {
      bf16_t* dst = hb + O_VD + ((size_t)(b * 4 + r4) * S + s) * 128;
#pragma unroll
      for (int nb = 0; nb < 4; ++nb) {
#pragma unroll
        for (int pq = 0; pq < 2; ++pq) {
          float v[8];
          swap8(acc[nb], pq, v);
          stage_put(sreg, m & 31, 4 * (nb & 1) + 2 * pq + h, pk8(v, rs, nullptr));
        }
        if (nb & 1) stage_flush(sreg, dst - (size_t)(m & 31) * 128 + 64 * (nb >> 1), 128);
      }
    }
  }
};

template <int DQK, int DV>
struct AL {
  static constexpr int KSTR = DQK * 2 + 16, VSTR = DV * 2 + 64, KBYTES = 64 * KSTR, VBYTES = 64 * VSTR, STAGE = KBYTES + VBYTES;
  static constexpr int KCH = DQK / 8, VCH = DV / 8;
  static constexpr int NKC = 8 * DQK, NVC = 8 * DV;
  static constexpr int NKR = (NKC + NT - 1) / NT, NVR = (NVC + NT - 1) / NT;
};

template <int DQK, int DV>
DI void a_gload(const bf16_t* Kt, const bf16_t* Vt, u32x4 (&rk)[AL<DQK, DV>::NKR], u32x4 (&rv)[AL<DQK, DV>::NVR], int tid) {
  typedef AL<DQK, DV> L;
#pragma unroll
  for (int q = 0; q < L::NKR; ++q) {
    const int c = tid + NT * q;
    if (c < L::NKC) rk[q] = *(const u32x4*)(Kt + (size_t)c * 8);
  }
#pragma unroll
  for (int q = 0; q < L::NVR; ++q) {
    const int c = tid + NT * q;
    if (c < L::NVC) rv[q] = *(const u32x4*)(Vt + (size_t)c * 8);
  }
}
template <int DQK, int DV>
DI void a_swrite(unsigned char* kl, unsigned char* vl, const u32x4 (&rk)[AL<DQK, DV>::NKR], const u32x4 (&rv)[AL<DQK, DV>::NVR], int tid) {
  typedef AL<DQK, DV> L;
#pragma unroll
  for (int q = 0; q < L::NKR; ++q) {
    const int c = tid + NT * q, row = c / L::KCH, cc = c - row * L::KCH;
    if (c < L::NKC) *(u32x4*)(kl + row * L::KSTR + cc * 16) = rk[q];
  }
#pragma unroll
  for (int q = 0; q < L::NVR; ++q) {
    const int c = tid + NT * q, row = c / L::VCH, cc = c - row * L::VCH;
    if (c < L::NVC) *(u32x4*)(vl + row * L::VSTR + cc * 16) = rv[q];
  }
}

template <int DV, int VSTR>
DI void v_load(const unsigned char* vl, int kb, int lane, bf16x8 (&vf)[2][DV / 32]) {
  const int h = lane >> 5, blk = (lane >> 4) & 1, q = (lane & 15) >> 2, pp = lane & 3;
  const unsigned char* a0 = vl + (32 * kb + 4 * h + q) * VSTR + (16 * blk + 4 * pp) * 2;
#pragma unroll
  for (int s2 = 0; s2 < 2; ++s2)
#pragma unroll
    for (int db = 0; db < DV / 32; ++db) {
      const unsigned char* a = a0 + 16 * s2 * VSTR + 64 * db;
      const s16x4 lo = __builtin_amdgcn_ds_read_tr16_b64_v4i16((LDS_AS s16x4*)(a));
      const s16x4 hi = __builtin_amdgcn_ds_read_tr16_b64_v4i16((LDS_AS s16x4*)(a + 8 * VSTR));
      vf[s2][db] = __builtin_shufflevector(lo, hi, 0, 1, 2, 3, 4, 5, 6, 7);
    }
}
template <int DV>
DI void pv_mma(const f32x16& p, const bf16x8 (&vf)[2][DV / 32], f32x16 (&O)[DV / 32]) {
#pragma unroll
  for (int s2 = 0; s2 < 2; ++s2) {
    const bf16x8 pf = pack8(p, 8 * s2);
#pragma unroll
    for (int db = 0; db < DV / 32; ++db) O[db] = MFMA(vf[s2][db], pf, O[db]);
  }
}

template <int MODE>
DI void attn_unit(const bf16_t* Qs, const bf16_t* Ks, const bf16_t* Vs, const bf16_t* Qs2, const bf16_t* Ks2, int qi, float slope2, float m0init,
                  float lam, float outscale, const float* subln, bf16_t* mixdst, float* stash, unsigned char* lds, float bnd0 = 0.f, float bnd1 = 0.f) {
  constexpr int DQK = (MODE == 1) ? 96 : 64, DV = (MODE == 3) ? 128 : 64, NDB = DV / 32, NKS = DQK / 16;
  typedef AL<DQK, DV> L;
  const int tid = opaque_tid(), lane = tid & 63, w = tid >> 6, h = lane >> 5, r = lane & 31;
  const int q0 = qi * 256;
  const int qrow = q0 + 32 * w + r;
  const int cw = (q0 + 32 * w) >> 6;
  const int gbw = (q0 + 32 * w) >> 5;
  const int jhi = 4 * qi + 3;
  int jlo = 0;
  if (MODE == 0) jlo = (4 * qi - 2) > 0 ? (4 * qi - 2) : 0;
  const int ntl = jhi - jlo + 1;
  constexpr int NPASS = (MODE == 3) ? 2 : 1;
#pragma unroll
  for (int pass = 0; pass < NPASS; ++pass) {
    const bf16_t* Qp = pass ? Qs2 : Qs;
    const bf16_t* Kp = pass ? Ks2 : Ks;
    bf16x8 qf[NKS];
#pragma unroll
    for (int s = 0; s < NKS; ++s) qf[s] = *(const bf16x8*)(Qp + (size_t)qrow * DQK + 16 * s + 8 * h);
    f32x16 O[NDB];
#pragma unroll
    for (int db = 0; db < NDB; ++db) O[db] = zero16();
    float m = (MODE == 0) ? m0init : -1e30f;
    float l = (MODE == 0 && h == 0) ? 1.f : 0.f;
    float c = 0.f;
    u32x4 rk[L::NKR], rv[L::NVR];
    {
      const int j0 = (MODE >= 2) ? jhi : jlo;
      a_gload<DQK, DV>(Kp + (size_t)j0 * 64 * DQK, Vs + (size_t)j0 * 64 * DV, rk, rv, tid);
      a_swrite<DQK, DV>(lds, lds + L::KBYTES, rk, rv, tid);
    }
    __builtin_amdgcn_s_waitcnt(0x0F70);
    __syncthreads();
    for (int it = 0; it < ntl; ++it) {
      const int j = (MODE >= 2) ? jhi - it : jlo + it;
      const bool more = it + 1 < ntl;
      if (more) {
        const int jn = (MODE >= 2) ? j - 1 : j + 1;
        a_gload<DQK, DV>(Kp + (size_t)jn * 64 * DQK, Vs + (size_t)jn * 64 * DV, rk, rv, tid);
      }
      const unsigned char* kl = lds + (it & 1) * L::STAGE;
      const unsigned char* vl = kl + L::KBYTES;
      if (MODE != 2) {
        const bool ok = (j <= cw) && (MODE != 0 || j >= cw - 2);
        if (ok && DV == 64) {
          f32x16 sc0 = zero16(), sc1 = zero16();
          bf16x8 vfa[2][NDB], vfb[2][NDB];
          {
            const unsigned char* kp = kl + r * L::KSTR + 16 * h;
            bf16x8 kf[NKS], kg[NKS];
#pragma unroll
            for (int s = 0; s < NKS; ++s) kf[s] = *(const bf16x8*)(kp + 32 * s);
            __builtin_amdgcn_sched_barrier(0);
#pragma unroll
            for (int s = 0; s < NKS; ++s) kg[s] = *(const bf16x8*)(kp + 32 * L::KSTR + 32 * s);
            __builtin_amdgcn_sched_barrier(0);
#pragma unroll
            for (int s = 0; s < NKS; ++s) sc0 = MFMA(kf[s], qf[s], sc0);
            __builtin_amdgcn_sched_barrier(0);
            v_load<DV, L::VSTR>(vl, 0, lane, vfa);
            v_load<DV, L::VSTR>(vl, 1, lane, vfb);
            __builtin_amdgcn_sched_barrier(0);
#pragma unroll
            for (int s = 0; s < NKS; ++s) sc1 = MFMA(kg[s], qf[s], sc1);
            __builtin_amdgcn_sched_barrier(0);
          }
          if (MODE == 0) {
            const float fl = (float)(qrow - (64 * j + 4 * h));
#pragma unroll
            for (int i = 0; i < 16; ++i) {
              sc0[i] = fmaf(-slope2, fabsf(fl - (float)((i & 3) + 8 * (i >> 2))), sc0[i]);
              sc1[i] = fmaf(-slope2, fabsf(fl - (float)(32 + (i & 3) + 8 * (i >> 2))), sc1[i]);
            }
          }
          float mx = fmaxf(sc0[0], sc1[0]);
#pragma unroll
          for (int i = 1; i < 16; ++i) mx = fmaxf(mx, fmaxf(sc0[i], sc1[i]));
          mx = fmaxf(mx, xor32(mx));
          const float mn = fmaxf(m, mx);
          if (__any(mn > m)) {
            const float alpha = ex2(m - mn);
            l *= alpha;
#pragma unroll
            for (int db = 0; db < NDB; ++db) O[db] = O[db] * alpha;
          }
          m = mn;
          float ps = 0.f;
#pragma unroll
          for (int i = 0; i < 16; ++i) { const float pe = ex2(sc0[i] - mn); sc0[i] = pe; ps += pe; }
          pv_mma<DV>(sc0, vfa, O);
#pragma unroll
          for (int i = 0; i < 16; ++i) { const float pe = ex2(sc1[i] - mn); sc1[i] = pe; ps += pe; }
          l += ps;
          pv_mma<DV>(sc1, vfb, O);
        } else if (ok) {
#pragma unroll 1
          for (int kb = 0; kb < 2; ++kb) {
            const unsigned char* kp = kl + (32 * kb + r) * L::KSTR + 16 * h;
            bf16x8 kf[NKS];
#pragma unroll
            for (int s = 0; s < NKS; ++s) kf[s] = *(const bf16x8*)(kp + 32 * s);
            bf16x8 vf[2][NDB];
            v_load<DV, L::VSTR>(vl, kb, lane, vf);
            __builtin_amdgcn_sched_barrier(0);
            const float fl = (float)(qrow - (64 * j + 32 * kb + 4 * h));
            const bool far = (MODE == 0 || MODE == 3) && (64 * j + 32 * kb + 31 < q0 + 32 * w);
            const float sl_i = far ? slope2 : 0.f;
            f32x16 sc;
#pragma unroll
            for (int i = 0; i < 16; ++i) sc[i] = sl_i * (float)((i & 3) + 8 * (i >> 2));
#pragma unroll
            for (int s = 0; s < NKS; ++s) sc = MFMA(kf[s], qf[s], sc);
            if ((MODE == 0 || MODE == 3) && !far) {
#pragma unroll
              for (int i = 0; i < 16; ++i) sc[i] = fmaf(-slope2, fabsf(fl - (float)((i & 3) + 8 * (i >> 2))), sc[i]);
            }
            const float u = far ? -slope2 * fl : 0.f;
            float mx = sc[0];
#pragma unroll
            for (int i = 1; i < 16; ++i) mx = fmaxf(mx, sc[i]);
            mx += u;
            mx = fmaxf(mx, xor32(mx));
            const float mn = fmaxf(m, mx);
            if (__any(mn > m)) {
              const float alpha = ex2(m - mn);
              l *= alpha;
#pragma unroll
              for (int db = 0; db < NDB; ++db) O[db] = O[db] * alpha;
            }
            m = mn;
            const float shift = mn - u;
            float ps = 0.f;
#pragma unroll
            for (int i = 0; i < 16; ++i) { const float pe = ex2(sc[i] - shift); sc[i] = pe; ps += pe; }
            l += ps;
            pv_mma<DV>(sc, vf, O);
          }
        }
      } else {
#pragma unroll 1
        for (int kk = 0; kk < 2; ++kk) {
          const int kb = 1 - kk;
          const int gb = 2 * j + kb;
          if (gb <= gbw) {
            const bool diag = gb == gbw;
            const unsigned char* kp = kl + (32 * kb + r) * L::KSTR + 16 * h;
            bf16x8 kf[NKS];
#pragma unroll
            for (int s = 0; s < NKS; ++s) kf[s] = *(const bf16x8*)(kp + 32 * s);
            bf16x8 vf[2][NDB];
            v_load<DV, L::VSTR>(vl, kb, lane, vf);
            __builtin_amdgcn_sched_barrier(0);
            f32x16 z = zero16();
#pragma unroll
            for (int s = 0; s < NKS; ++s) z = MFMA(kf[s], qf[s], z);
            f32x16 sp;
#pragma unroll
            for (int i = 0; i < 16; ++i) {
              const float zi = z[i];
              const float e = ex2(-fabsf(zi));
              float v = fmaxf(zi, 0.f) + lg2(1.f + e);
              const int key = (i & 3) + 8 * (i >> 2) + 4 * h;
              if (diag && key >= r) v = 0.f;
              sp[i] = v;
            }
            float Tg[4], Tp[4], offs[4];
#pragma unroll
            for (int g = 0; g < 4; ++g) { Tg[g] = (sp[4 * g] + sp[4 * g + 1]) + (sp[4 * g + 2] + sp[4 * g + 3]); Tp[g] = xor32(Tg[g]); }
            float run = 0.f;
#pragma unroll
            for (int g = 3; g >= 0; --g) { offs[g] = run + (h == 0 ? Tp[g] : 0.f); run += Tg[g] + Tp[g]; }
#pragma unroll
            for (int g = 3; g >= 0; --g) {
              float a = c + offs[g];
#pragma unroll
              for (int e = 3; e >= 0; --e) {
                const int i = 4 * g + e;
                a += sp[i];
                float pe = ex2(z[i] - a);
                const int key = (i & 3) + 8 * (i >> 2) + 4 * h;
                if (diag && key >= r) pe = 0.f;
                z[i] = pe;
              }
            }
            c += run;
            pv_mma<DV>(z, vf, O);
          }
        }
      }
      if (more) {
        unsigned char* kn = lds + ((it + 1) & 1) * L::STAGE;
        a_swrite<DQK, DV>(kn, kn + L::KBYTES, rk, rv, tid);
      }
      if (MODE == 3) {
        volatile int* fl = (volatile int*)(lds + LDS_TILE_BYTES) + (it & 1) * 8;
        const float dmin = (float)((q0 + 32 * w) - (64 * j - 1));
        const float bnd = pass ? bnd1 : bnd0;
        const int done = __all(bnd - slope2 * dmin < m - 150.f) ? 1 : 0;
        if (lane == 0) fl[w] = done;
        __syncthreads();
        if (fl[0] + fl[1] + fl[2] + fl[3] + fl[4] + fl[5] + fl[6] + fl[7] == 8) break;
      } else if (MODE == 2) {
        volatile int* fl = (volatile int*)(lds + LDS_TILE_BYTES) + (it & 1) * 8;
        const int done = __all(c > 160.f) ? 1 : 0;
        if (lane == 0) fl[w] = done;
        __syncthreads();
        if (fl[0] + fl[1] + fl[2] + fl[3] + fl[4] + fl[5] + fl[6] + fl[7] == 8) break;
      } else
        __syncthreads();
    }
    bf16_t* orow = mixdst + (size_t)(32 * w + r) * DM;
    if (MODE == 2) {
#pragma unroll
      for (int db = 0; db < NDB; ++db)
#pragma unroll
        for (int pq = 0; pq < 2; ++pq) {
          float v[8];
          swap8(O[db], pq, v);
          st8(orow + 32 * db + 8 * (2 * pq + h), v, 1.f, nullptr);
        }
    } else {
      const float lt = l + xor32(l);
      const float inv = 1.f / lt;
      if (MODE != 3) {
#pragma unroll
        for (int db = 0; db < NDB; ++db)
#pragma unroll
          for (int pq = 0; pq < 2; ++pq) {
            float v[8];
            swap8(O[db], pq, v);
            st8(orow + 32 * db + 8 * (2 * pq + h), v, inv, nullptr);
          }
      } else if (pass == 0) {
#pragma unroll
        for (int db = 0; db < NDB; ++db)
#pragma unroll
          for (int g = 0; g < 4; ++g) {
            f32x4 v = {O[db][4 * g] * inv, O[db][4 * g + 1] * inv, O[db][4 * g + 2] * inv, O[db][4 * g + 3] * inv};
            *(f32x4*)(stash + tid * 64 + db * 16 + 4 * g) = v;
          }
      } else {
        const float li = lam * inv;
        float ss = 0.f;
#pragma unroll
        for (int db = 0; db < NDB; ++db)
#pragma unroll
          for (int g = 0; g < 4; ++g) {
            const f32x4 o1 = *(const f32x4*)(stash + tid * 64 + db * 16 + 4 * g);
#pragma unroll
            for (int e = 0; e < 4; ++e) { const float v = o1[e] - li * O[db][4 * g + e]; O[db][4 * g + e] = v; ss = fmaf(v, v, ss); }
          }
        ss += xor32(ss);
        const float rr = rsqrtf(ss * (1.f / 128.f) + EPS) * outscale;
#pragma unroll
        for (int db = 0; db < NDB; ++db)
#pragma unroll
          for (int pq = 0; pq < 2; ++pq) {
            const int d = 32 * db + 8 * (2 * pq + h);
            float v[8];
            swap8(O[db], pq, v);
            st8(orow + d, v, rr, subln + d);
          }
      }
    }
  }
}

DI int next_unit(int* ctr, unsigned char* lds) {
  volatile int* slot = (volatile int*)(lds + LDS_TILE_BYTES + 64);
  if (threadIdx.x == 0) *slot = atomicAdd(ctr, 1);
  __syncthreads();
  const int u = *slot;
  __syncthreads();
  return u;
}

DI void attn_even(const Params& p, int j, int*  , unsigned char* lds) {
  bf16_t* hb = (bf16_t*)(p.ws + WS_HID);
  bf16_t* mix = (bf16_t*)(p.ws + WS_MIX);
  int* qbase = (int*)(p.ws + WS_CTR) + 16 + j * 8;
  for (int xo = 0; xo < 8; ++xo) {
    const int hd = (blockIdx.x + xo) & 7;
    for (;;) {
      int v = next_unit(qbase + hd, lds);
      if (v >= 256) break;
      if (v < 128) {
        const int qi = 31 - (v >> 2), b = v & 3;
        const size_t sl = (size_t)(b * 8 + hd) * S;
        attn_unit<1>(hb + E_QB + sl * 96, hb + E_KB + sl * 96, hb + E_VB + sl * 64, nullptr, nullptr, qi, 0.f, 0.f, 0.f, 0.f, nullptr,
                     mix + ((size_t)b * S + qi * 256) * DM + 512 + hd * 64, nullptr, lds);
      } else {
        v -= 128;
        const int qi = 31 - (v >> 2), b = v & 3, g = hd >> 2;
        const size_t sl = (size_t)(b * 8 + hd) * S, slk = (size_t)(b * 2 + g) * S;
        const float slope2 = exp2f(-(float)(hd + 1)) * LOG2E;
        const float m0 = p.in[10][j * 8 + hd] * LOG2E;
        attn_unit<0>(hb + E_QA + sl * 64, hb + E_KA + slk * 64, hb + E_VA + slk * 64, nullptr, nullptr, qi, slope2, m0, 0.f, 0.f, nullptr,
                     mix + ((size_t)b * S + qi * 256) * DM + hd * 64, nullptr, lds);
      }
    }
  }
}

DI void attn_odd(const Params& p, int j, int* ctr, unsigned char* lds) {
  bf16_t* hb = (bf16_t*)(p.ws + WS_HID);
  bf16_t* mix = (bf16_t*)(p.ws + WS_MIX);
  const float* lf = p.in[21] + j * 256;
  float d01 = 0.f, d23 = 0.f;
  for (int i = 0; i < 64; ++i) { d01 = fmaf(lf[i], lf[64 + i], d01); d23 = fmaf(lf[128 + i], lf[192 + i], d23); }
  const float lambda_init = 0.8f - 0.6f * expf(-0.3f * (float)(2 * j + 1));
  const float lam = expf(d01) - expf(d23) + lambda_init;
  float bnd[2];
  for (int wh = 0; wh < 2; ++wh) {
    float gq = 0.f, gk = 0.f;
    for (int i = 0; i < 64; ++i) { gq = fmaxf(gq, fabsf(p.in[19][j * 128 + wh * 64 + i])); gk = fmaxf(gk, fabsf(p.in[20][j * 128 + wh * 64 + i])); }
    bnd[wh] = 8.f * LOG2E * 1.01f * gq * gk;
  }
  int* qbase = (int*)(p.ws + WS_CTR) + 32 + j * 8;
  for (int xo = 0; xo < 8; ++xo) {
    const int x = (blockIdx.x + xo) & 7;
    for (;;) {
      int v = next_unit(qbase + x, lds);
      if (v >= 192) break;
      if (v < 64) {
        const int qi = 31 - (v >> 1), b = x >> 1;
        const int hd = (v & 1) ? ((x & 1) ? 0 : 1) : ((x & 1) ? 3 : 2);
        const size_t sl0 = (size_t)((b * 4 + hd) * 2) * S, slv = (size_t)(b * 4 + hd) * S;
        const float slope2 = exp2f(-2.f * (float)(hd + 1)) * LOG2E;
        attn_unit<3>(hb + O_QD + sl0 * 64, hb + O_KD + sl0 * 64, hb + O_VD + slv * 128, hb + O_QD + (sl0 + S) * 64, hb + O_KD + (sl0 + S) * 64, qi, slope2,
                     0.f, lam, 1.f - lambda_init, p.in[22] + j * 128, mix + ((size_t)b * S + qi * 256) * DM + 512 + hd * 128,
                     (float*)(p.ws + WS_STASH) + (size_t)blockIdx.x * 32768, lds, bnd[0], bnd[1]);
      } else {
        v -= 64;
        const int qi = 31 - (v >> 2), b = v & 3, hd = x;
        const size_t sl = (size_t)(b * 8 + hd) * S;
        attn_unit<2>(hb + O_QC + sl * 64, hb + O_KC + sl * 64, hb + O_VC + sl * 64, nullptr, nullptr, qi, 0.f, 0.f, 0.f, 0.f, nullptr,
                     mix + ((size_t)b * S + qi * 256) * DM + hd * 64, nullptr, lds);
      }
    }
  }
}

#define XB_TMO      128
#define XB_XCNT(j)  (256  + 64 * (j))
#define XB_XSUB(j)  (1280 + 64 * (j))
#define XB_XGEN(j)  (2304 + 64 * (j))
#define XB_TOP      3328
#define XB_TOPGEN   3392
#define XCD_BAR_WORDS 3456
#define XB_SPIN_CAP (1u << 22)
DI unsigned xb_ld(unsigned* p) { return __hip_atomic_load(p, __ATOMIC_RELAXED, __HIP_MEMORY_SCOPE_AGENT); }
DI unsigned xb_add(unsigned* p, unsigned v) { return __hip_atomic_fetch_add(p, v, __ATOMIC_RELAXED, __HIP_MEMORY_SCOPE_AGENT); }
DI unsigned xb_xcc_id() { return (unsigned)__builtin_amdgcn_s_getreg((3 << 11) | 20) & 0xFu; }
#define XB_SPIN(cond, bar) do { unsigned _sp = 0; while (cond) { __builtin_amdgcn_s_sleep(1); \
    if ((++_sp & 255u) == 0u) { if (xb_ld(&(bar)[XB_TMO])) break; if (_sp > XB_SPIN_CAP) { atomicAdd(&(bar)[XB_TMO], 1u); break; } } } } while (0)
struct XcdBarrier { unsigned* bar; unsigned x; volatile LDS_AS unsigned* st; };
DI XcdBarrier xcd_barrier_post(unsigned* bar, volatile LDS_AS unsigned* st) {
  XcdBarrier b; b.bar = bar; b.x = xb_xcc_id(); b.st = st;
  if (threadIdx.x == 0) (void)xb_add(&bar[XB_XCNT(b.x)], 1u);
  return b;
}
DI void xcd_barrier_complete(unsigned* bar, unsigned x, unsigned& nloc, unsigned& nx) {
  const unsigned G = gridDim.x * gridDim.y * gridDim.z;
  unsigned sum, cnt, mine, sp = 0u;
  for (;;) {
    sum = 0u; cnt = 0u; mine = 0u;
#pragma unroll
    for (unsigned j = 0; j < 16; ++j) { const unsigned c = xb_ld(&bar[XB_XCNT(j)]); sum += c; cnt += (c > 0u) ? 1u : 0u; mine = (j == x) ? c : mine; }
    if (sum == G) break;
    __builtin_amdgcn_s_sleep(1);
    if ((++sp & 255u) == 0u) { if (xb_ld(&bar[XB_TMO])) break; if (sp > XB_SPIN_CAP) { atomicAdd(&bar[XB_TMO], 1u); break; } }
  }
  nloc = mine > 0u ? mine : 1u; nx = cnt > 0u ? cnt : 1u;
}
DI void xcd_barrier(const XcdBarrier& b) {
  asm volatile("s_waitcnt vmcnt(0)" ::: "memory");
  __syncthreads();
  if (threadIdx.x == 0) {
    unsigned* bar = b.bar;
    __builtin_amdgcn_s_waitcnt(0);
    unsigned nloc = b.st[0], nx = b.st[1];
    if (nloc == 0u) { xcd_barrier_complete(bar, b.x, nloc, nx); b.st[0] = nloc; b.st[1] = nx; }
    const unsigned old = xb_add(&bar[XB_XSUB(b.x)], 1u);
    const unsigned gen = old / nloc;
    if (old + 1u == (gen + 1u) * nloc) {
      __builtin_amdgcn_fence(__ATOMIC_RELEASE, "agent");
      asm volatile("s_waitcnt vmcnt(0)" ::: "memory");
      const unsigned og = xb_add(&bar[XB_TOP], 1u);
      const unsigned tg = og / nx;
      if (og + 1u == (tg + 1u) * nx) xb_add(&bar[XB_TOPGEN], 1u);
      else XB_SPIN(xb_ld(&bar[XB_TOPGEN]) == tg, bar);
      __builtin_amdgcn_fence(__ATOMIC_ACQUIRE, "agent");
      xb_add(&bar[XB_XGEN(b.x)], 1u);
      asm volatile("s_waitcnt vmcnt(0)" ::: "memory");
    } else {
      XB_SPIN(xb_ld(&bar[XB_XGEN(b.x)]) == gen, bar);
      __builtin_amdgcn_fence(__ATOMIC_ACQUIRE, "agent");
      asm volatile("s_waitcnt vmcnt(0)" ::: "memory");
    }
  }
  __syncthreads();
}

enum { K_PRO = 0, K_IN_E, K_UP_E, K_ATT_E, K_IN_O, K_ATT_O, K_OUT, K_MLPUP, K_DOWN };

extern "C" __global__ void __launch_bounds__(512) fwd_kernel(Params p, int ph_lo, int ph_hi) {
  extern __shared__ __attribute__((aligned(16))) unsigned char lds[];
  cg::grid_group grid = cg::this_grid();
  volatile LDS_AS unsigned* xst = (volatile LDS_AS unsigned*)(lds + LDS_TILE_BYTES + 96);
  if (threadIdx.x == 0) { xst[0] = 0u; xst[1] = 0u; }
  __syncthreads();
  XcdBarrier gbar = xcd_barrier_post((unsigned*)(p.ws + WS_BAR), xst);
  unsigned char* wb = p.ws + WS_W;
  bf16_t* xb = (bf16_t*)(p.ws + WS_XB);
  bf16_t* mix = (bf16_t*)(p.ws + WS_MIX);
  bf16_t* hb = (bf16_t*)(p.ws + WS_HID);
  int* ctr = (int*)(p.ws + WS_CTR);
  const int* pos = (const int*)p.in[1];
  for (int ph = ph_lo; ph < ph_hi; ++ph) {
    int kind = K_PRO, L = 0;
    if (ph > 0) {
      const int q = ph - 1, pair = q / 11, rr = q - pair * 11;
      if (rr < 6) { L = 2 * pair; kind = rr == 0 ? K_IN_E : rr == 1 ? K_UP_E : rr == 2 ? K_ATT_E : rr == 3 ? K_OUT : rr == 4 ? K_MLPUP : K_DOWN; }
      else { L = 2 * pair + 1; kind = rr == 6 ? K_IN_O : rr == 7 ? K_ATT_O : rr == 8 ? K_OUT : rr == 9 ? K_MLPUP : K_DOWN; }
    }
    const int j = L >> 1;
    for (int rep = 0; rep < ((kind == PROBE_KIND) ? 2 : 1); ++rep) {
    if (kind == K_PRO) {
      prologue(p, lds);
    } else if (kind == K_IN_E) {
      EpiEvenIn e{hb, p.in[8] + j * 64, p.in[9] + j * 64, p.in[12] + j * 128, lds};
      gemm_phase<true>(xb, 1024, (const bf16_t*)(wb + W_IN_E) + (size_t)j * 1280 * 1024, 1024, 5, e, lds);
    } else if (kind == K_UP_E) {
      EpiUQ e1{hb + E_QB, p.in[15] + j * 96, pos};
      gemm_phase<true>(hb + E_CQ, 256, (const bf16_t*)(wb + W_UQ) + (size_t)j * 1024 * 256, 256, 4, e1, lds);
      EpiUKV e2{hb + E_KB, hb + E_VB, (const float*)(hb + E_KR), p.in[16] + j * 96, pos};
      gemm_phase<false>(hb + E_CKV, 128, (const bf16_t*)(wb + W_UKV) + (size_t)j * 1024 * 128, 128, 4, e2, lds);
    } else if (kind == K_ATT_E) {
      attn_even(p, j, ctr + L + 4 * rep, lds);
    } else if (kind == K_IN_O) {
      EpiOddIn e{hb, p.in[19] + j * 128, p.in[20] + j * 128, lds};
      gemm_phase<true>(xb, 1024, (const bf16_t*)(wb + W_IN_O) + (size_t)j * 3072 * 1024, 1024, 12, e, lds);
    } else if (kind == K_ATT_O) {
      attn_odd(p, j, ctr + L + 4 * rep, lds);
    } else if (kind == K_OUT || kind == K_DOWN) {
      const bool isout = kind == K_OUT;
      EpiResid e{(isout && L == 0) ? p.in[0] : nullptr, xb, (!isout && L == 3) ? p.out : nullptr, lds};
      const bf16_t* Bt = isout ? ((L & 1) ? (const bf16_t*)(wb + W_OUT_O) : (const bf16_t*)(wb + W_OUT_E)) + (size_t)j * 1024 * 1024
                               : (const bf16_t*)(wb + W_DN) + (size_t)L * 1024 * 4096;
      gemm_phase<false>(isout ? mix : hb, isout ? 1024 : 4096, Bt, isout ? 1024 : 4096, 4, e, lds);
    } else {
      EpiRelu2 e{hb, lds};
      gemm_phase<true>(xb, 1024, (const bf16_t*)(wb + W_UP) + (size_t)L * 4096 * 1024, 1024, 16, e, lds);
    }
    if (PROBE_KIND >= 0) __syncthreads();
    }
    if (ph + 1 < ph_hi) {
      if (ph == ph_lo) grid.sync();
      else xcd_barrier(gbar);
    }
  }
}

extern "C" void kernel_launch(void* const* d_in, const int* in_sizes, int n_in, void* d_out, int out_size, void* d_ws, size_t ws_size,
                              hipStream_t stream) {
  static int grid_blocks = 0;
  if (grid_blocks == 0) {
    if (n_in != 23 || out_size != T * DM || ws_size < WS_END) {
      fprintf(stderr, "kernel_launch: unexpected shapes (n_in %d out %d ws %zu need %zu)\n", n_in, out_size, ws_size, (size_t)WS_END);
      grid_blocks = -1;
      return;
    }
    int dev = 0, cus = 0, per_cu = 0;
    hipGetDevice(&dev);
    hipDeviceGetAttribute(&cus, hipDeviceAttributeMultiprocessorCount, dev);
    if (hipFuncSetAttribute((const void*)fwd_kernel, hipFuncAttributeMaxDynamicSharedMemorySize, LDS_BYTES) != hipSuccess)
      fprintf(stderr, "kernel_launch: hipFuncSetAttribute failed\n");
    hipOccupancyMaxActiveBlocksPerMultiprocessor(&per_cu, (const void*)fwd_kernel, NT, LDS_BYTES);
    if (per_cu > 1) per_cu = 1;
    if (per_cu < 1) { fprintf(stderr, "kernel_launch: occupancy query gave %d\n", per_cu); per_cu = 1; }
    grid_blocks = cus * per_cu;
  }
  if (grid_blocks < 0) return;
  Params p{};
  for (int i = 0; i < 23; ++i) p.in[i] = (const float*)d_in[i];
  p.out = (float*)d_out;
  p.ws = (unsigned char*)d_ws;
  if (hipMemsetAsync((char*)d_ws + WS_BAR, 0, 16384, stream) != hipSuccess) fprintf(stderr, "kernel_launch: memset of barrier words failed\n");
#if MULTI_LAUNCH
  for (int ph = 0; ph < NPHASE; ++ph) hipLaunchKernelGGL(fwd_kernel, dim3(grid_blocks), dim3(NT), LDS_BYTES, stream, p, ph, ph + 1);
#else
  int lo = 0, hi = NPHASE;
  void* args[] = {&p, &lo, &hi};
  hipError_t e = hipLaunchCooperativeKernel((const void*)fwd_kernel, dim3(grid_blocks), dim3(NT), args, LDS_BYTES, stream);
  if (e != hipSuccess) fprintf(stderr, "cooperative launch failed: %s (grid %d)\n", hipGetErrorString(e), grid_blocks);
#endif
}
```

```cpp
#include <hip/hip_runtime.h>
#include <hip/hip_cooperative_groups.h>
#include <cstdio>
#include <cstdint>
namespace cg = cooperative_groups;

#ifndef PROBE_KIND
#define PROBE_KIND -1
#endif
#ifndef MULTI_LAUNCH
#define MULTI_LAUNCH 0
#endif

typedef unsigned short bf16_t;
typedef short bf16x8 __attribute__((ext_vector_type(8)));
typedef short s16x4 __attribute__((ext_vector_type(4)));
typedef float f32x16 __attribute__((ext_vector_type(16)));
typedef float f32x4 __attribute__((ext_vector_type(4)));
typedef float f32x2 __attribute__((ext_vector_type(2)));
typedef __bf16 bf16x2_t __attribute__((ext_vector_type(2)));
typedef unsigned u32x2 __attribute__((ext_vector_type(2)));
typedef unsigned u32x4 __attribute__((ext_vector_type(4)));
#define DI __device__ __forceinline__
#define LDS_AS __attribute__((address_space(3)))

constexpr int T = 32768, S = 8192, DM = 1024, DFF = 4096;
constexpr float EPS = 1e-6f;
constexpr float LOG2E = 1.4426950408889634f;
constexpr int NPHASE = 23;
constexpr int NT = 512;
constexpr int LDS_TILE_BYTES = 147456;
constexpr int LDS_BYTES = LDS_TILE_BYTES + 128;

constexpr size_t MiB = 1024 * 1024;
constexpr size_t WS_XB = 0;
constexpr size_t WS_MIX = 64 * MiB;
constexpr size_t WS_HID = 128 * MiB;
constexpr size_t WS_W = 384 * MiB;
constexpr size_t W_IN_E = 0;
constexpr size_t W_UQ = W_IN_E + 2ull * 1280 * 1024 * 2;
constexpr size_t W_UKV = W_UQ + 2ull * 1024 * 256 * 2;
constexpr size_t W_OUT_E = W_UKV + 2ull * 1024 * 128 * 2;
constexpr size_t W_IN_O = W_OUT_E + 2ull * 1024 * 1024 * 2;
constexpr size_t W_OUT_O = W_IN_O + 2ull * 3072 * 1024 * 2;
constexpr size_t W_UP = W_OUT_O + 2ull * 1024 * 1024 * 2;
constexpr size_t W_DN = W_UP + 4ull * 4096 * 1024 * 2;
constexpr size_t W_END = W_DN + 4ull * 4096 * 1024 * 2;
constexpr size_t WS_CTR = WS_W + W_END;
constexpr size_t WS_BAR = WS_CTR + 256;
constexpr size_t WS_STASH = WS_BAR + 16384;
constexpr size_t WS_END = WS_STASH + 256ull * 131072;
constexpr size_t TE = (size_t)T;
constexpr size_t E_QA = 0, E_KA = E_QA + TE * 512, E_VA = E_KA + TE * 128, E_CQ = E_VA + TE * 128, E_CKV = E_CQ + TE * 256,
                 E_QB = E_CKV + TE * 128, E_KB = E_QB + TE * 768, E_VB = E_KB + TE * 768, E_KR = E_VB + TE * 512  ;
constexpr size_t O_QC = 0, O_KC = TE * 512, O_VC = TE * 1024, O_QD = TE * 1536, O_KD = TE * 2048, O_VD = TE * 2560;

struct Params {
  const float* in[23];
  float* out;
  unsigned char* ws;
};

DI unsigned pack2(float lo, float hi) {
  f32x2 f = {lo, hi};
  bf16x2_t b = __builtin_convertvector(f, bf16x2_t);
  return __builtin_bit_cast(unsigned, b);
}
DI void st4(bf16_t* p, float a, float b, float c, float d) {
  u32x2 v = {pack2(a, b), pack2(c, d)};
  *(u32x2*)p = v;
}
DI bf16x8 pack8(const f32x16& x, int o) {
  u32x4 v = {pack2(x[o], x[o + 1]), pack2(x[o + 2], x[o + 3]), pack2(x[o + 4], x[o + 5]), pack2(x[o + 6], x[o + 7])};
  return __builtin_bit_cast(bf16x8, v);
}
DI float ex2(float x) { return __builtin_amdgcn_exp2f(x); }
DI float lg2(float x) { return __builtin_amdgcn_logf(x); }
DI float xor32(float x) { return __shfl_xor(x, 32); }
#define MFMA(a, b, c) __builtin_amdgcn_mfma_f32_32x32x16_bf16((a), (b), (c), 0, 0, 0)
DI int opaque_tid() { int t = threadIdx.x; asm volatile("" : "+v"(t)); return t; }
DI f32x16 zero16() { f32x16 z; for (int i = 0; i < 16; ++i) z[i] = 0.f; return z; }

DI void tconv(const float* __restrict__ src, const float* __restrict__ gain, int N, int K, bf16_t* __restrict__ dst, int Npad, int grp,
              int grp_pad, unsigned char* lds) {
  const int tid5 = opaque_tid();
  const int half = tid5 >> 8, tid = tid5 & 255;
  float* tile = (float*)lds + half * (64 * 33);
  const int nkt = K >> 6, ntl = (Npad >> 5) * nkt;
  for (int tt = blockIdx.x; 2 * tt < ntl; tt += gridDim.x) {
    const int t = 2 * tt + half;
    const bool active = t < ntl;
    const int ntile = t / nkt, kt = t - ntile * nkt;
    const int np0 = ntile * 32, k0 = kt * 64;
    const int gi = np0 / grp_pad, go = np0 - gi * grp_pad;
    const int sn0 = gi * grp + go;
    const bool valid = active && (go < grp) && (sn0 < N);
    if (valid) {
#pragma unroll
      for (int p = 0; p < 2; ++p) {
        const int kk = (tid >> 3) + 32 * p, nn = (tid & 7) * 4;
        const f32x4 v = *(const f32x4*)(src + (size_t)(k0 + kk) * N + sn0 + nn);
        const float gsc = gain ? gain[k0 + kk] : 1.f;
#pragma unroll
        for (int e = 0; e < 4; ++e) tile[kk * 33 + nn + e] = v[e] * gsc;
      }
    }
    __syncthreads();
    if (active) {
      const int n = tid >> 3, kq = (tid & 7) * 8;
      u32x4 o = {0u, 0u, 0u, 0u};
      if (valid) {
        float f[8];
#pragma unroll
        for (int j = 0; j < 8; ++j) f[j] = tile[(kq + j) * 33 + n];
        o[0] = pack2(f[0], f[1]); o[1] = pack2(f[2], f[3]); o[2] = pack2(f[4], f[5]); o[3] = pack2(f[6], f[7]);
      }
      *(u32x4*)(dst + (size_t)(np0 + n) * K + k0 + kq) = o;
    }
    __syncthreads();
  }
}

DI void prologue(const Params& p, unsigned char* lds) {
  unsigned char* wb = p.ws + WS_W;
  if (blockIdx.x == 0 && threadIdx.x < 64) ((int*)(p.ws + WS_CTR))[threadIdx.x] = 0;
  {
    const float* x = p.in[0];
    bf16_t* xb = (bf16_t*)(p.ws + WS_XB);
    const size_t n8 = (size_t)T * DM / 8;
    for (size_t i = (size_t)blockIdx.x * NT + threadIdx.x; i < n8; i += (size_t)gridDim.x * NT) {
      const f32x4 a = *(const f32x4*)(x + i * 8), b = *(const f32x4*)(x + i * 8 + 4);
      u32x4 o = {pack2(a[0], a[1]), pack2(a[2], a[3]), pack2(b[0], b[1]), pack2(b[2], b[3])};
      *(u32x4*)(xb + i * 8) = o;
    }
  }
  for (int j = 0; j < 2; ++j) {
    tconv(p.in[6] + (size_t)j * 1024 * 1184, p.in[2] + (2 * j) * 1024, 1184, 1024, (bf16_t*)(wb + W_IN_E) + (size_t)j * 1280 * 1024, 1280, 1280, 1280, lds);
    tconv(p.in[13] + (size_t)j * 256 * 768, p.in[11] + j * 256, 768, 256, (bf16_t*)(wb + W_UQ) + (size_t)j * 1024 * 256, 1024, 96, 128, lds);
    tconv(p.in[14] + (size_t)j * 128 * 1024, nullptr, 1024, 128, (bf16_t*)(wb + W_UKV) + (size_t)j * 1024 * 128, 1024, 1024, 1024, lds);
    tconv(p.in[7] + (size_t)j * 1024 * 1024, nullptr, 1024, 1024, (bf16_t*)(wb + W_OUT_E) + (size_t)j * 1024 * 1024, 1024, 1024, 1024, lds);
    tconv(p.in[17] + (size_t)j * 1024 * 3072, p.in[2] + (2 * j + 1) * 1024, 3072, 1024, (bf16_t*)(wb + W_IN_O) + (size_t)j * 3072 * 1024, 3072, 3072, 3072, lds);
    tconv(p.in[18] + (size_t)j * 1024 * 1024, nullptr, 1024, 1024, (bf16_t*)(wb + W_OUT_O) + (size_t)j * 1024 * 1024, 1024, 1024, 1024, lds);
  }
  for (int L = 0; L < 4; ++L) {
    tconv(p.in[4] + (size_t)L * 1024 * 4096, p.in[3] + L * 1024, 4096, 1024, (bf16_t*)(wb + W_UP) + (size_t)L * 4096 * 1024, 4096, 4096, 4096, lds);
    tconv(p.in[5] + (size_t)L * 4096 * 1024, nullptr, 1024, 4096, (bf16_t*)(wb + W_DN) + (size_t)L * 1024 * 4096, 1024, 1024, 1024, lds);
  }
}

constexpr int G_OP = 256 * 64;
constexpr int G_STAGE = 2 * G_OP;
constexpr int G_NST = 4;
static_assert(G_NST * G_STAGE <= LDS_TILE_BYTES, "LDS ring");

DI void tile_map(int t, int Ntiles, int& mt, int& nt) {
  const int xcd = t & 7, j = t >> 3;
  const int per = 4 * Ntiles;
  const int g = j / per, r = j - g * per;
  nt = r >> 2;
  mt = (g * 4 + (r & 3)) * 8 + xcd;
}

template <bool ROWSS>
DI void frag_ss(const bf16x8& af, float& ss) {
  if (ROWSS) {
    typedef __bf16 bf2 __attribute__((ext_vector_type(2)));
    typedef __bf16 bf8 __attribute__((ext_vector_type(8)));
    const bf8 v = __builtin_bit_cast(bf8, af);
#pragma unroll
    for (int e = 0; e < 4; ++e) {
      const bf2 t = {v[2 * e], v[2 * e + 1]};
      ss = __builtin_amdgcn_fdot2_f32_bf16(t, t, ss, false);
    }
  }
}

DI void lds_barrier() {
  __builtin_amdgcn_s_waitcnt(0xC07F);
  __builtin_amdgcn_s_barrier();
  asm volatile("" ::: "memory");
}

template <bool ROWSS, class Epi>
DI void gemm_phase(const bf16_t* A, int lda, const bf16_t* Bt, int K, int Ntiles, const Epi& epi, unsigned char* lds) {
  const int tid = opaque_tid(), lane = tid & 63, w = tid >> 6, h = lane >> 5, r = lane & 31;
  const int wm = w & 3, wn = w >> 2;
  const int ntiles = (T / 256) * Ntiles;
  const int nk = K >> 5;
  const int fsw = (h ^ ((r >> 2) & 3)) * 16;
  const int a_off = (64 * wm + r) * 64 + fsw;
  const int b_off = G_OP + (128 * wn + r) * 64 + fsw;
  const int grow = lane >> 2, gch = ((lane & 3) ^ ((lane >> 4) & 3)) * 8;
  const int wu = __builtin_amdgcn_readfirstlane(w);
  int t = blockIdx.x;
  int m0 = 0, nt = 0;
  const bf16_t* ag = A;
  const bf16_t* bg = Bt;
  auto set_tile = [&](int tt) {
    int mt_;
    tile_map(tt, Ntiles, mt_, nt);
    m0 = mt_ * 256;
    ag = A + (size_t)(m0 + 16 * w + grow) * lda + gch;
    bg = Bt + (size_t)(nt * 256 + 16 * w + grow) * K + gch;
  };
  bool primed = false;
  while (t < ntiles) {
    auto glds1 = [&](int kt, int piece) {
      unsigned char* st = lds + (kt & (G_NST - 1)) * G_STAGE + wu * 1024;
      const int k0 = kt * 32;
      if (piece == 0) __builtin_amdgcn_global_load_lds((const unsigned*)(ag + k0), (unsigned*)(st), 16, 0, 0);
      if (piece == 1) __builtin_amdgcn_global_load_lds((const unsigned*)(ag + (size_t)128 * lda + k0), (unsigned*)(st + 8192), 16, 0, 0);
      if (piece == 2) __builtin_amdgcn_global_load_lds((const unsigned*)(bg + k0), (unsigned*)(st + G_OP), 16, 0, 0);
      if (piece == 3) __builtin_amdgcn_global_load_lds((const unsigned*)(bg + (size_t)128 * K + k0), (unsigned*)(st + G_OP + 8192), 16, 0, 0);
    };
    auto glds = [&](int kt) { glds1(kt, 0); glds1(kt, 1); glds1(kt, 2); glds1(kt, 3); };
    if (!primed) {
      set_tile(t);
      asm volatile("s_waitcnt vmcnt(0)" ::: "memory");
      glds(0); glds(1); glds(2);
      primed = true;
    }
    f32x16 acc[2][4];
#pragma unroll
    for (int mb = 0; mb < 2; ++mb)
#pragma unroll
      for (int nb = 0; nb < 4; ++nb) acc[mb][nb] = zero16();
    float ss0 = 0.f, ss1 = 0.f;
    bf16x8 af0[2], wf0[4], af1[2], wf1[4];
    for (int kt = 0; kt < nk; ++kt) {
      if (kt + 2 < nk) asm volatile("s_waitcnt vmcnt(4)" ::: "memory"); else asm volatile("s_waitcnt vmcnt(0)" ::: "memory");
      lds_barrier();
      const bool pf = kt + 3 < nk;
      const unsigned char* sc = lds + (kt & (G_NST - 1)) * G_STAGE;
      if (kt == 0) {
#pragma unroll
        for (int mb = 0; mb < 2; ++mb) af0[mb] = *(const bf16x8*)(sc + a_off + 2048 * mb);
#pragma unroll
        for (int nb = 0; nb < 4; ++nb) wf0[nb] = *(const bf16x8*)(sc + b_off + 2048 * nb);
      }
#pragma unroll
      for (int mb = 0; mb < 2; ++mb) af1[mb] = *(const bf16x8*)(sc + (a_off ^ 32) + 2048 * mb);
#pragma unroll
      for (int nb = 0; nb < 4; ++nb) wf1[nb] = *(const bf16x8*)(sc + (b_off ^ 32) + 2048 * nb);
      __builtin_amdgcn_sched_barrier(0);
      frag_ss<ROWSS>(af0[0], ss0);
      frag_ss<ROWSS>(af0[1], ss1);
#pragma unroll
      for (int nb = 0; nb < 4; ++nb) {
#pragma unroll
        for (int mb = 0; mb < 2; ++mb) acc[mb][nb] = MFMA(wf0[nb], af0[mb], acc[mb][nb]);
        if (nb == 1) { __builtin_amdgcn_sched_barrier(0); if (pf) glds1(kt + 3, 0); __builtin_amdgcn_sched_barrier(0); }
        if (nb == 3) { __builtin_amdgcn_sched_barrier(0); if (pf) glds1(kt + 3, 1); }
      }
      __builtin_amdgcn_sched_barrier(0);
      __builtin_amdgcn_sched_barrier(0);
      frag_ss<ROWSS>(af1[0], ss0);
      frag_ss<ROWSS>(af1[1], ss1);
#pragma unroll
      for (int nb = 0; nb < 4; ++nb) {
#pragma unroll
        for (int mb = 0; mb < 2; ++mb) acc[mb][nb] = MFMA(wf1[nb], af1[mb], acc[mb][nb]);
        if (nb == 0) {
          __builtin_amdgcn_sched_barrier(0);
          if (kt + 1 < nk) {
            const unsigned char* sn = lds + ((kt + 1) & (G_NST - 1)) * G_STAGE;
#pragma unroll
            for (int mb = 0; mb < 2; ++mb) af0[mb] = *(const bf16x8*)(sn + a_off + 2048 * mb);
#pragma unroll
            for (int nb2 = 0; nb2 < 4; ++nb2) wf0[nb2] = *(const bf16x8*)(sn + b_off + 2048 * nb2);
          }
          __builtin_amdgcn_sched_barrier(0);
        }
        if (nb == 1) { __builtin_amdgcn_sched_barrier(0); if (pf) glds1(kt + 3, 2); __builtin_amdgcn_sched_barrier(0); }
        if (nb == 3) { __builtin_amdgcn_sched_barrier(0); if (pf) glds1(kt + 3, 3); }
      }
      __builtin_amdgcn_sched_barrier(0);
    }
    lds_barrier();
    float rs0 = 1.f, rs1 = 1.f;
    if (ROWSS) {
      ss0 += xor32(ss0);
      ss1 += xor32(ss1);
      rs0 = rsqrtf(ss0 / (float)K + EPS);
      rs1 = rsqrtf(ss1 / (float)K + EPS);
    }
    const int mrow = m0 + 64 * wm + r, nt128 = 2 * nt + wn;
    t += gridDim.x;
    if (t < ntiles) { set_tile(t); glds(0); glds(1); glds(2); }
    epi(acc[0], mrow, nt128, h, rs0);
    epi(acc[1], mrow + 32, nt128, h, rs1);
  }
}

DI void swap8(const f32x16& a, int p, float (&v)[8]) {
#pragma unroll
  for (int e = 0; e < 4; ++e) {
    const auto r = __builtin_amdgcn_permlane32_swap(__float_as_uint(a[8 * p + e]), __float_as_uint(a[8 * p + 4 + e]), false, false);
    v[e] = __uint_as_float(r[0]);
    v[4 + e] = __uint_as_float(r[1]);
  }
}
DI u32x4 pk8(const float (&v)[8], float r, const float* gain) {
  float o[8];
  if (gain) {
    const f32x4 g0 = *(const f32x4*)(gain), g1 = *(const f32x4*)(gain + 4);
#pragma unroll
    for (int e = 0; e < 4; ++e) { o[e] = v[e] * r * g0[e]; o[4 + e] = v[4 + e] * r * g1[e]; }
  } else {
#pragma unroll
    for (int e = 0; e < 8; ++e) o[e] = v[e] * r;
  }
  return (u32x4){pack2(o[0], o[1]), pack2(o[2], o[3]), pack2(o[4], o[5]), pack2(o[6], o[7])};
}
DI void st8(bf16_t* p, const float (&v)[8], float r, const float* gain) {
  float o[8];
  if (gain) {
    const f32x4 g0 = *(const f32x4*)(gain), g1 = *(const f32x4*)(gain + 4);
#pragma unroll
    for (int e = 0; e < 4; ++e) { o[e] = v[e] * r * g0[e]; o[4 + e] = v[4 + e] * r * g1[e]; }
  } else {
#pragma unroll
    for (int e = 0; e < 8; ++e) o[e] = v[e] * r;
  }
  u32x4 u = {pack2(o[0], o[1]), pack2(o[2], o[3]), pack2(o[4], o[5]), pack2(o[6], o[7])};
  *(u32x4*)p = u;
}
constexpr int EPI_LDS = 3 * G_STAGE;
DI void stage_put(unsigned char* reg, int r, int chunk, const u32x4& o) { *(u32x4*)(reg + r * 128 + ((chunk ^ (r & 7)) << 4)) = o; }
DI void stage_flush(unsigned char* reg, bf16_t* dst0, size_t ld) {
  const int lane = opaque_tid() & 63;
  __builtin_amdgcn_s_waitcnt(0xC07F);
#pragma unroll
  for (int q = 0; q < 4; ++q) {
    const int row = 8 * q + (lane >> 3), phys = lane & 7;
    const u32x4 v = *(const u32x4*)(reg + row * 128 + (phys << 4));
    *(u32x4*)(dst0 + (size_t)row * ld + ((phys ^ (row & 7)) << 3)) = v;
  }
  __builtin_amdgcn_s_waitcnt(0xC07F);
  __builtin_amdgcn_sched_barrier(0);
}
struct EpiResid {
  const float* res_f32; bf16_t* xb; float* out_f32; unsigned char* lds;
  DI void operator()(f32x16 (&acc)[4], int m, int nt, int h, float) const {
    const size_t base = (size_t)m * DM + nt * 128;
    const int r = m & 31;
    unsigned char* reg = lds + EPI_LDS + (opaque_tid() >> 6) * 4096;
#pragma unroll
    for (int nb = 0; nb < 4; ++nb) {
#pragma unroll
      for (int p = 0; p < 2; ++p) {
        const int c = 32 * nb + 8 * (2 * p + h);
        float v[8];
        swap8(acc[nb], p, v);
        if (res_f32) {
          const f32x4 r0 = *(const f32x4*)(res_f32 + base + c), r1 = *(const f32x4*)(res_f32 + base + c + 4);
#pragma unroll
          for (int e = 0; e < 4; ++e) { v[e] += r0[e]; v[4 + e] += r1[e]; }
        } else {
          const u32x4 u = *(const u32x4*)(xb + base + c);
#pragma unroll
          for (int e = 0; e < 4; ++e) { v[2 * e] += __uint_as_float(u[e] << 16); v[2 * e + 1] += __uint_as_float(u[e] & 0xffff0000u); }
        }
        if (out_f32) {
          *(f32x4*)(out_f32 + base + c) = (f32x4){v[0], v[1], v[2], v[3]};
          *(f32x4*)(out_f32 + base + c + 4) = (f32x4){v[4], v[5], v[6], v[7]};
        } else {
          const u32x4 o = {pack2(v[0], v[1]), pack2(v[2], v[3]), pack2(v[4], v[5]), pack2(v[6], v[7])};
          stage_put(reg, r, 4 * (nb & 1) + 2 * p + h, o);
        }
      }
      if (!out_f32 && (nb & 1)) stage_flush(reg, xb + (size_t)(m - r) * DM + nt * 128 + 64 * (nb >> 1), DM);
    }
  }
};
struct EpiRelu2 {
  bf16_t* hid; unsigned char* lds;
  DI void operator()(f32x16 (&acc)[4], int m, int nt, int h, float rs) const {
    const int r = m & 31;
    unsigned char* reg = lds + EPI_LDS + (opaque_tid() >> 6) * 4096;
    bf16_t* blk = hid + (size_t)(m - r) * DFF + nt * 128;
#pragma unroll
    for (int ch = 0; ch < 2; ++ch) {
#pragma unroll
      for (int nb2 = 0; nb2 < 2; ++nb2)
#pragma unroll
        for (int p = 0; p < 2; ++p) {
          float v[8];
          swap8(acc[2 * ch + nb2], p, v);
#pragma unroll
          for (int e = 0; e < 8; ++e) { const float a = fmaxf(v[e] * rs, 0.f); v[e] = a * a; }
          const u32x4 o = {pack2(v[0], v[1]), pack2(v[2], v[3]), pack2(v[4], v[5]), pack2(v[6], v[7])};
          stage_put(reg, r, 4 * nb2 + 2 * p + h, o);
        }
      stage_flush(reg, blk + 64 * ch, DFF);
    }
  }
};
constexpr float QS_64 = 0.125f * LOG2E;
constexpr float QS_96 = 0.10206207261596575f * LOG2E;

struct EpiEvenIn {
  bf16_t* hb; const float *a_qg, *a_kg, *b_ckvg; unsigned char* lds;
  DI void operator()(f32x16 (&acc)[4], int m, int nt, int h, float rs) const {
    const int b = m >> 13, s = m & (S - 1);
    unsigned char* sreg = lds + EPI_LDS + (opaque_tid() >> 6) * 4096;
    if (nt < 6) {
#pragma unroll
      for (int hh = 0; hh < 2; ++hh) {
        float r = rs;
        const float* gain = nullptr;
        bf16_t* dst;
        if (nt < 5) {
          float ss = 0.f;
#pragma unroll
          for (int x = 0; x < 2; ++x)
#pragma unroll
            for (int i = 0; i < 16; ++i) { const float v = acc[2 * hh + x][i] * rs; ss = fmaf(v, v, ss); }
          ss += xor32(ss);
          r = rsqrtf(ss * (1.f / 64.f) + EPS) * rs;
          if (nt < 4) { gain = a_qg; r *= QS_64; } else gain = a_kg;
        }
        {
          const size_t off = (nt < 4) ? E_QA + ((size_t)(b * 8 + 2 * nt + hh) * S + s) * 64
                                      : E_KA + (size_t)(nt - 4) * (TE * 128) + ((size_t)(b * 2 + hh) * S + s) * 64;
          dst = hb + off;
        }
#pragma unroll
        for (int x = 0; x < 2; ++x)
#pragma unroll
          for (int pq = 0; pq < 2; ++pq) {
            const int d = 32 * x + 8 * (2 * pq + h);
            float v[8];
            swap8(acc[2 * hh + x], pq, v);
            stage_put(sreg, m & 31, 4 * x + 2 * pq + h, pk8(v, r, gain ? gain + d : nullptr));
          }
        stage_flush(sreg, dst - (m & 31) * 64, 64);
      }
    } else if (nt < 8) {
      bf16_t* dst = hb + E_CQ + (size_t)m * 256 + (nt - 6) * 128;
#pragma unroll
      for (int nb = 0; nb < 4; ++nb) {
#pragma unroll
        for (int pq = 0; pq < 2; ++pq) {
          float v[8];
          swap8(acc[nb], pq, v);
          stage_put(sreg, m & 31, 4 * (nb & 1) + 2 * pq + h, pk8(v, rs, nullptr));
        }
        if (nb & 1) stage_flush(sreg, dst - (size_t)(m & 31) * 256 + 64 * (nb >> 1), 256);
      }
    } else if (nt == 8) {
      float ss = 0.f;
#pragma unroll
      for (int nb = 0; nb < 4; ++nb)
#pragma unroll
        for (int i = 0; i < 16; ++i) { const float v = acc[nb][i] * rs; ss = fmaf(v, v, ss); }
      ss += xor32(ss);
      const float r = rsqrtf(ss * (1.f / 128.f) + EPS) * rs;
      bf16_t* dst = hb + E_CKV + (size_t)m * 128;
#pragma unroll
      for (int nb = 0; nb < 4; ++nb) {
#pragma unroll
        for (int pq = 0; pq < 2; ++pq) {
          const int c = 32 * nb + 8 * (2 * pq + h);
          float v[8];
          swap8(acc[nb], pq, v);
          stage_put(sreg, m & 31, 4 * (nb & 1) + 2 * pq + h, pk8(v, r, b_ckvg + c));
        }
        if (nb & 1) stage_flush(sreg, dst - (size_t)(m & 31) * 128 + 64 * (nb >> 1), 128);
      }
    } else {
      float* dst = (float*)(hb + E_KR) + (size_t)m * 32;
#pragma unroll
      for (int g = 0; g < 4; ++g) {
        f32x4 v = {acc[0][4 * g] * rs, acc[0][4 * g + 1] * rs, acc[0][4 * g + 2] * rs, acc[0][4 * g + 3] * rs};
        *(f32x4*)(dst + 8 * g + 4 * h) = v;
      }
    }
  }
};

DI void sincos_cw(float x, float& sn, float& cs) {
  const float k = rintf(x * 0.63661977236758134f);
  float r = fmaf(-k, 1.57079637050628662109375f, x);
  r = fmaf(-k, -4.37113900018624283e-8f, r);
  const int q = (int)k;
  const float r2 = r * r;
  const float sp = fmaf(r * r2, fmaf(r2, fmaf(r2, -1.9515295891e-4f, 8.3321608736e-3f), -1.6666654611e-1f), r);
  const float cp = fmaf(r2 * r2, fmaf(r2, fmaf(r2, 2.443315711809948e-5f, -1.388731625493765e-3f), 4.166664568298827e-2f), fmaf(r2, -0.5f, 1.f));
  const float s0 = (q & 1) ? cp : sp, c0 = (q & 1) ? sp : cp;
  sn = (q & 2) ? -s0 : s0;
  cs = ((q + 1) & 2) ? -c0 : c0;
}
DI constexpr float rope_inv(int i) {
  return i == 0 ? 1.f : i == 1 ? 0.5623413251903491f : i == 2 ? 0.31622776601683794f : i == 3 ? 0.1778279410038923f : i == 4 ? 0.1f
       : i == 5 ? 0.05623413251903491f : i == 6 ? 0.031622776601683794f : i == 7 ? 0.01778279410038923f : i == 8 ? 0.01f
       : i == 9 ? 0.005623413251903491f : i == 10 ? 0.0031622776601683794f : i == 11 ? 0.001778279410038923f : i == 12 ? 0.001f
       : i == 13 ? 0.0005623413251903491f : i == 14 ? 0.00031622776601683794f : 0.0001778279410038923f;
}
DI void rope4(const float (&y1)[4], const float (&y2)[4], int gg, int h, float posf, float (&o1)[4], float (&o2)[4]) {
#pragma unroll
  for (int e = 0; e < 4; ++e) {
    const float inv = h ? rope_inv(8 * gg + 4 + e) : rope_inv(8 * gg + e);
    const float ang = posf * inv;
    float sn, cs;
    sincos_cw(ang, sn, cs);
    o1[e] = y1[e] * cs - y2[e] * sn;
    o2[e] = y1[e] * sn + y2[e] * cs;
  }
}

struct EpiUQ {
  bf16_t* QB; const float* b_qg; const int* pos;
  DI void operator()(f32x16 (&acc)[4], int m, int nt, int h, float rs) const {
    const int b = m >> 13, s = m & (S - 1);
    float ss = 0.f;
#pragma unroll
    for (int nb = 0; nb < 3; ++nb)
#pragma unroll
      for (int i = 0; i < 16; ++i) { const float v = acc[nb][i] * rs; ss = fmaf(v, v, ss); }
    ss += xor32(ss);
    const float r = rsqrtf(ss * (1.f / 96.f) + EPS) * rs * QS_96;
    bf16_t* dst = QB + ((size_t)(b * 8 + nt) * S + s) * 96;
#pragma unroll
    for (int nb = 0; nb < 2; ++nb)
#pragma unroll
      for (int pq = 0; pq < 2; ++pq) {
        const int c = 32 * nb + 8 * (2 * pq + h);
        float v[8];
        swap8(acc[nb], pq, v);
        st8(dst + c, v, r, b_qg + c);
      }
    const float posf = (float)pos[m];
#pragma unroll
    for (int gg = 0; gg < 2; ++gg) {
      const int ri0 = 8 * gg + 4 * h;
      const f32x4 g1 = *(const f32x4*)(b_qg + 64 + ri0), g2 = *(const f32x4*)(b_qg + 80 + ri0);
      float y1[4], y2[4], o1[4], o2[4];
#pragma unroll
      for (int e = 0; e < 4; ++e) { y1[e] = acc[2][4 * gg + e] * r * g1[e]; y2[e] = acc[2][4 * gg + 8 + e] * r * g2[e]; }
      rope4(y1, y2, gg, h, posf, o1, o2);
      st4(dst + 64 + ri0, o1[0], o1[1], o1[2], o1[3]);
      st4(dst + 80 + ri0, o2[0], o2[1], o2[2], o2[3]);
    }
  }
};

struct EpiUKV {
  bf16_t *KB, *VB; const float* KR; const float* b_kg; const int* pos;
  DI void operator()(f32x16 (&acc)[4], int m, int nt, int h, float) const {
    const int b = m >> 13, s = m & (S - 1);
    f32x4 k1[2], k2[2];
    float ss = 0.f;
#pragma unroll
    for (int gg = 0; gg < 2; ++gg) {
      k1[gg] = *(const f32x4*)(KR + (size_t)m * 32 + 8 * gg + 4 * h);
      k2[gg] = *(const f32x4*)(KR + (size_t)m * 32 + 16 + 8 * gg + 4 * h);
#pragma unroll
      for (int e = 0; e < 4; ++e) { ss = fmaf(k1[gg][e], k1[gg][e], ss); ss = fmaf(k2[gg][e], k2[gg][e], ss); }
    }
#pragma unroll
    for (int nb = 0; nb < 2; ++nb)
#pragma unroll
      for (int i = 0; i < 16; ++i) ss = fmaf(acc[nb][i], acc[nb][i], ss);
    ss += xor32(ss);
    const float r = rsqrtf(ss * (1.f / 96.f) + EPS);
    bf16_t* dst = KB + ((size_t)(b * 8 + nt) * S + s) * 96;
#pragma unroll
    for (int nb = 0; nb < 2; ++nb)
#pragma unroll
      for (int pq = 0; pq < 2; ++pq) {
        const int c = 32 * nb + 8 * (2 * pq + h);
        float v[8];
        swap8(acc[nb], pq, v);
        st8(dst + c, v, r, b_kg + c);
      }
    const float posf = (float)pos[m];
#pragma unroll
    for (int gg = 0; gg < 2; ++gg) {
      const int ri0 = 8 * gg + 4 * h;
      const f32x4 g1 = *(const f32x4*)(b_kg + 64 + ri0), g2 = *(const f32x4*)(b_kg + 80 + ri0);
      float y1[4], y2[4], o1[4], o2[4];
#pragma unroll
      for (int e = 0; e < 4; ++e) { y1[e] = k1[gg][e] * r * g1[e]; y2[e] = k2[gg][e] * r * g2[e]; }
      rope4(y1, y2, gg, h, posf, o1, o2);
      st4(dst + 64 + ri0, o1[0], o1[1], o1[2], o1[3]);
      st4(dst + 80 + ri0, o2[0], o2[1], o2[2], o2[3]);
    }
    bf16_t* vd = VB + ((size_t)(b * 8 + nt) * S + s) * 64;
#pragma unroll
    for (int nb = 2; nb < 4; ++nb)
#pragma unroll
      for (int pq = 0; pq < 2; ++pq) {
        float v[8];
        swap8(acc[nb], pq, v);
        st8(vd + 32 * (nb - 2) + 8 * (2 * pq + h), v, 1.f, nullptr);
      }
  }
};

struct EpiOddIn {
  bf16_t* hb; const float *d_qg, *d_kg; unsigned char* lds;
  DI void operator()(f32x16 (&acc)[4], int m, int nt, int h, float rs) const {
    const int b = m >> 13, s = m & (S - 1);
    unsigned char* sreg = lds + EPI_LDS + (opaque_tid() >> 6) * 4096;
    const int region = nt >> 2, r4 = nt & 3;
    if (region < 5) {
#pragma unroll
      for (int hh = 0; hh < 2; ++hh) {
        float r = rs;
        const float* gain = nullptr;
        bf16_t* dst;
        if (region < 3) {
          if (region == 0) r *= QS_64;
          dst = hb + (size_t)region * (TE * 512) + ((size_t)(b * 8 + 2 * r4 + hh) * S + s) * 64;
        } else {
          float ss = 0.f;
#pragma unroll
          for (int x = 0; x < 2; ++x)
#pragma unroll
            for (int i = 0; i < 16; ++i) { const float v = acc[2 * hh + x][i] * rs; ss = fmaf(v, v, ss); }
          ss += xor32(ss);
          r = rsqrtf(ss * (1.f / 64.f) + EPS) * rs;
          if (region == 3) { gain = d_qg + hh * 64; r *= QS_64; } else gain = d_kg + hh * 64;
          dst = hb + (size_t)region * (TE * 512) + ((size_t)((b * 4 + r4) * 2 + hh) * S + s) * 64;
        }
#pragma unroll
        for (int x = 0; x < 2; ++x)
#pragma unroll
          for (int pq = 0; pq < 2; ++pq) {
            const int d = 32 * x + 8 * (2 * pq + h);
            float v[8];
            swap8(acc[2 * hh + x], pq, v);
            stage_put(sreg, m & 31, 4 * x + 2 * pq + h, pk8(v, r, gain ? gain + d : nullptr));
          }
        stage_flush(sreg, dst - (m & 31) * 64, 64);
      }
    } else {
      bf16_t* dst = hb + O_VD + ((size_t)(b * 4 + r4) * S + s) * 128;
#pragma unroll
      for (int nb = 0; nb < 4; ++nb) {
#pragma unroll
        for (int pq = 0; pq < 2; ++pq) {
          float v[8];
          swap8(acc[nb], pq, v);
          stage_put(sreg, m & 31, 4 * (nb & 1) + 2 * pq + h, pk8(v, rs, nullptr));
        }
        if (nb & 1) stage_flush(sreg, dst - (size_t)(m & 31) * 128 + 64 * (nb >> 1), 128);
      }
    }
  }
};

template <int DQK, int DV>
struct AL {
  static constexpr int KSTR = DQK * 2 + 16, VSTR = DV * 2 + 64, KBYTES = 64 * KSTR, VBYTES = 64 * VSTR, STAGE = KBYTES + VBYTES;
  static constexpr int KCH = DQK / 8, VCH = DV / 8;
  static constexpr int NKC = 8 * DQK, NVC = 8 * DV;
  static constexpr int NKR = (NKC + NT - 1) / NT, NVR = (NVC + NT - 1) / NT;
};

template <int DQK, int DV>
DI void a_gload(const bf16_t* Kt, const bf16_t* Vt, u32x4 (&rk)[AL<DQK, DV>::NKR], u32x4 (&rv)[AL<DQK, DV>::NVR], int tid) {
  typedef AL<DQK, DV> L;
#pragma unroll
  for (int q = 0; q < L::NKR; ++q) {
    const int c = tid + NT * q;
    if (c < L::NKC) rk[q] = *(const u32x4*)(Kt + (size_t)c * 8);
  }
#pragma unroll
  for (int q = 0; q < L::NVR; ++q) {
    const int c = tid + NT * q;
    if (c < L::NVC) rv[q] = *(const u32x4*)(Vt + (size_t)c * 8);
  }
}
template <int DQK, int DV>
DI void a_swrite(unsigned char* kl, unsigned char* vl, const u32x4 (&rk)[AL<DQK, DV>::NKR], const u32x4 (&rv)[AL<DQK, DV>::NVR], int tid) {
  typedef AL<DQK, DV> L;
#pragma unroll
  for (int q = 0; q < L::NKR; ++q) {
    const int c = tid + NT * q, row = c / L::KCH, cc = c - row * L::KCH;
    if (c < L::NKC) *(u32x4*)(kl + row * L::KSTR + cc * 16) = rk[q];
  }
#pragma unroll
  for (int q = 0; q < L::NVR; ++q) {
    const int c = tid + NT * q, row = c / L::VCH, cc = c - row * L::VCH;
    if (c < L::NVC) *(u32x4*)(vl + row * L::VSTR + cc * 16) = rv[q];
  }
}

template <int DV, int VSTR>
DI void v_load(const unsigned char* vl, int kb, int lane, bf16x8 (&vf)[2][DV / 32]) {
  const int h = lane >> 5, blk = (lane >> 4) & 1, q = (lane & 15) >> 2, pp = lane & 3;
  const unsigned char* a0 = vl + (32 * kb + 4 * h + q) * VSTR + (16 * blk + 4 * pp) * 2;
#pragma unroll
  for (int s2 = 0; s2 < 2; ++s2)
#pragma unroll
    for (int db = 0; db < DV / 32; ++db) {
      const unsigned char* a = a0 + 16 * s2 * VSTR + 64 * db;
      const s16x4 lo = __builtin_amdgcn_ds_read_tr16_b64_v4i16((LDS_AS s16x4*)(a));
      const s16x4 hi = __builtin_amdgcn_ds_read_tr16_b64_v4i16((LDS_AS s16x4*)(a + 8 * VSTR));
      vf[s2][db] = __builtin_shufflevector(lo, hi, 0, 1, 2, 3, 4, 5, 6, 7);
    }
}
template <int DV>
DI void pv_mma(const f32x16& p, const bf16x8 (&vf)[2][DV / 32], f32x16 (&O)[DV / 32]) {
#pragma unroll
  for (int s2 = 0; s2 < 2; ++s2) {
    const bf16x8 pf = pack8(p, 8 * s2);
#pragma unroll
    for (int db = 0; db < DV / 32; ++db) O[db] = MFMA(vf[s2][db], pf, O[db]);
  }
}

template <int MODE>
DI void attn_unit(const bf16_t* Qs, const bf16_t* Ks, const bf16_t* Vs, const bf16_t* Qs2, const bf16_t* Ks2, int qi, float slope2, float m0init,
                  float lam, float outscale, const float* subln, bf16_t* mixdst, float* stash, unsigned char* lds, float bnd0 = 0.f, float bnd1 = 0.f) {
  constexpr int DQK = (MODE == 1) ? 96 : 64, DV = (MODE == 3) ? 128 : 64, NDB = DV / 32, NKS = DQK / 16;
  typedef AL<DQK, DV> L;
  const int tid = opaque_tid(), lane = tid & 63, w = tid >> 6, h = lane >> 5, r = lane & 31;
  const int q0 = qi * 256;
  const int qrow = q0 + 32 * w + r;
  const int cw = (q0 + 32 * w) >> 6;
  const int gbw = (q0 + 32 * w) >> 5;
  const int jhi = 4 * qi + 3;
  int jlo = 0;
  if (MODE == 0) jlo = (4 * qi - 2) > 0 ? (4 * qi - 2) : 0;
  const int ntl = jhi - jlo + 1;
  constexpr int NPASS = (MODE == 3) ? 2 : 1;
#pragma unroll
  for (int pass = 0; pass < NPASS; ++pass) {
    const bf16_t* Qp = pass ? Qs2 : Qs;
    const bf16_t* Kp = pass ? Ks2 : Ks;
    bf16x8 qf[NKS];
#pragma unroll
    for (int s = 0; s < NKS; ++s) qf[s] = *(const bf16x8*)(Qp + (size_t)qrow * DQK + 16 * s + 8 * h);
    f32x16 O[NDB];
#pragma unroll
    for (int db = 0; db < NDB; ++db) O[db] = zero16();
    float m = (MODE == 0) ? m0init : -1e30f;
    float l = (MODE == 0 && h == 0) ? 1.f : 0.f;
    float c = 0.f;
    u32x4 rk[L::NKR], rv[L::NVR];
    {
      const int j0 = (MODE >= 2) ? jhi : jlo;
      a_gload<DQK, DV>(Kp + (size_t)j0 * 64 * DQK, Vs + (size_t)j0 * 64 * DV, rk, rv, tid);
      a_swrite<DQK, DV>(lds, lds + L::KBYTES, rk, rv, tid);
    }
    __builtin_amdgcn_s_waitcnt(0x0F70);
    __syncthreads();
    for (int it = 0; it < ntl; ++it) {
      const int j = (MODE >= 2) ? jhi - it : jlo + it;
      const bool more = it + 1 < ntl;
      if (more) {
        const int jn = (MODE >= 2) ? j - 1 : j + 1;
        a_gload<DQK, DV>(Kp + (size_t)jn * 64 * DQK, Vs + (size_t)jn * 64 * DV, rk, rv, tid);
      }
      const unsigned char* kl = lds + (it & 1) * L::STAGE;
      const unsigned char* vl = kl + L::KBYTES;
      if (MODE != 2) {
        const bool ok = (j <= cw) && (MODE != 0 || j >= cw - 2);
        if (ok && DV == 64) {
          f32x16 sc0 = zero16(), sc1 = zero16();
          bf16x8 vfa[2][NDB], vfb[2][NDB];
          {
            const unsigned char* kp = kl + r * L::KSTR + 16 * h;
            bf16x8 kf[NKS], kg[NKS];
#pragma unroll
            for (int s = 0; s < NKS; ++s) kf[s] = *(const bf16x8*)(kp + 32 * s);
            __builtin_amdgcn_sched_barrier(0);
#pragma unroll
            for (int s = 0; s < NKS; ++s) kg[s] = *(const bf16x8*)(kp + 32 * L::KSTR + 32 * s);
            __builtin_amdgcn_sched_barrier(0);
#pragma unroll
            for (int s = 0; s < NKS; ++s) sc0 = MFMA(kf[s], qf[s], sc0);
            __builtin_amdgcn_sched_barrier(0);
            v_load<DV, L::VSTR>(vl, 0, lane, vfa);
            v_load<DV, L::VSTR>(vl, 1, lane, vfb);
            __builtin_amdgcn_sched_barrier(0);
#pragma unroll
            for (int s = 0; s < NKS; ++s) sc1 = MFMA(kg[s], qf[s], sc1);
            __builtin_amdgcn_sched_barrier(0);
          }
          if (MODE == 0) {
            const float fl = (float)(qrow - (64 * j + 4 * h));
#pragma unroll
            for (int i = 0; i < 16; ++i) {
              sc0[i] = fmaf(-slope2, fabsf(fl - (float)((i & 3) + 8 * (i >> 2))), sc0[i]);
              sc1[i] = fmaf(-slope2, fabsf(fl - (float)(32 + (i & 3) + 8 * (i >> 2))), sc1[i]);
            }
          }
          float mx = fmaxf(sc0[0], sc1[0]);
#pragma unroll
          for (int i = 1; i < 16; ++i) mx = fmaxf(mx, fmaxf(sc0[i], sc1[i]));
          mx = fmaxf(mx, xor32(mx));
          const float mn = fmaxf(m, mx);
          if (__any(mn > m)) {
            const float alpha = ex2(m - mn);
            l *= alpha;
#pragma unroll
            for (int db = 0; db < NDB; ++db) O[db] = O[db] * alpha;
          }
          m = mn;
          float ps = 0.f;
#pragma unroll
          for (int i = 0; i < 16; ++i) { const float pe = ex2(sc0[i] - mn); sc0[i] = pe; ps += pe; }
          pv_mma<DV>(sc0, vfa, O);
#pragma unroll
          for (int i = 0; i < 16; ++i) { const float pe = ex2(sc1[i] - mn); sc1[i] = pe; ps += pe; }
          l += ps;
          pv_mma<DV>(sc1, vfb, O);
        } else if (ok) {
#pragma unroll 1
          for (int kb = 0; kb < 2; ++kb) {
            const unsigned char* kp = kl + (32 * kb + r) * L::KSTR + 16 * h;
            bf16x8 kf[NKS];
#pragma unroll
            for (int s = 0; s < NKS; ++s) kf[s] = *(const bf16x8*)(kp + 32 * s);
            bf16x8 vf[2][NDB];
            v_load<DV, L::VSTR>(vl, kb, lane, vf);
            __builtin_amdgcn_sched_barrier(0);
            const float fl = (float)(qrow - (64 * j + 32 * kb + 4 * h));
            const bool far = (MODE == 0 || MODE == 3) && (64 * j + 32 * kb + 31 < q0 + 32 * w);
            const float sl_i = far ? slope2 : 0.f;
            f32x16 sc;
#pragma unroll
            for (int i = 0; i < 16; ++i) sc[i] = sl_i * (float)((i & 3) + 8 * (i >> 2));
#pragma unroll
            for (int s = 0; s < NKS; ++s) sc = MFMA(kf[s], qf[s], sc);
            if ((MODE == 0 || MODE == 3) && !far) {
#pragma unroll
              for (int i = 0; i < 16; ++i) sc[i] = fmaf(-slope2, fabsf(fl - (float)((i & 3) + 8 * (i >> 2))), sc[i]);
            }
            const float u = far ? -slope2 * fl : 0.f;
            float mx = sc[0];
#pragma unroll
            for (int i = 1; i < 16; ++i) mx = fmaxf(mx, sc[i]);
            mx += u;
            mx = fmaxf(mx, xor32(mx));
            const float mn = fmaxf(m, mx);
            if (__any(mn > m)) {
              const float alpha = ex2(m - mn);
              l *= alpha;
#pragma unroll
              for (int db = 0; db < NDB; ++db) O[db] = O[db] * alpha;
            }
            m = mn;
            const float shift = mn - u;
            float ps = 0.f;
#pragma unroll
            for (int i = 0; i < 16; ++i) { const float pe = ex2(sc[i] - shift); sc[i] = pe; ps += pe; }
            l += ps;
            pv_mma<DV>(sc, vf, O);
          }
        }
      } else {
#pragma unroll 1
        for (int kk = 0; kk < 2; ++kk) {
          const int kb = 1 - kk;
          const int gb = 2 * j + kb;
          if (gb <= gbw) {
            const bool diag = gb == gbw;
            const unsigned char* kp = kl + (32 * kb + r) * L::KSTR + 16 * h;
            bf16x8 kf[NKS];
#pragma unroll
            for (int s = 0; s < NKS; ++s) kf[s] = *(const bf16x8*)(kp + 32 * s);
            bf16x8 vf[2][NDB];
            v_load<DV, L::VSTR>(vl, kb, lane, vf);
            __builtin_amdgcn_sched_barrier(0);
            f32x16 z = zero16();
#pragma unroll
            for (int s = 0; s < NKS; ++s) z = MFMA(kf[s], qf[s], z);
            f32x16 sp;
#pragma unroll
            for (int i = 0; i < 16; ++i) {
              const float zi = z[i];
              const float e = ex2(-fabsf(zi));
              float v = fmaxf(zi, 0.f) + lg2(1.f + e);
              const int key = (i & 3) + 8 * (i >> 2) + 4 * h;
              if (diag && key >= r) v = 0.f;
              sp[i] = v;
            }
            float Tg[4], Tp[4], offs[4];
#pragma unroll
            for (int g = 0; g < 4; ++g) { Tg[g] = (sp[4 * g] + sp[4 * g + 1]) + (sp[4 * g + 2] + sp[4 * g + 3]); Tp[g] = xor32(Tg[g]); }
            float run = 0.f;
#pragma unroll
            for (int g = 3; g >= 0; --g) { offs[g] = run + (h == 0 ? Tp[g] : 0.f); run += Tg[g] + Tp[g]; }
#pragma unroll
            for (int g = 3; g >= 0; --g) {
              float a = c + offs[g];
#pragma unroll
              for (int e = 3; e >= 0; --e) {
                const int i = 4 * g + e;
                a += sp[i];
                float pe = ex2(z[i] - a);
                const int key = (i & 3) + 8 * (i >> 2) + 4 * h;
                if (diag && key >= r) pe = 0.f;
                z[i] = pe;
              }
            }
            c += run;
            pv_mma<DV>(z, vf, O);
          }
        }
      }
      if (more) {
        unsigned char* kn = lds + ((it + 1) & 1) * L::STAGE;
        a_swrite<DQK, DV>(kn, kn + L::KBYTES, rk, rv, tid);
      }
      if (MODE == 3) {
        volatile int* fl = (volatile int*)(lds + LDS_TILE_BYTES) + (it & 1) * 8;
        const float dmin = (float)((q0 + 32 * w) - (64 * j - 1));
        const float bnd = pass ? bnd1 : bnd0;
        const int done = __all(bnd - slope2 * dmin < m - 150.f) ? 1 : 0;
        if (lane == 0) fl[w] = done;
        __syncthreads();
        if (fl[0] + fl[1] + fl[2] + fl[3] + fl[4] + fl[5] + fl[6] + fl[7] == 8) break;
      } else if (MODE == 2) {
        volatile int* fl = (volatile int*)(lds + LDS_TILE_BYTES) + (it & 1) * 8;
        const int done = __all(c > 160.f) ? 1 : 0;
        if (lane == 0) fl[w] = done;
        __syncthreads();
        if (fl[0] + fl[1] + fl[2] + fl[3] + fl[4] + fl[5] + fl[6] + fl[7] == 8) break;
      } else
        __syncthreads();
    }
    bf16_t* orow = mixdst + (size_t)(32 * w + r) * DM;
    if (MODE == 2) {
#pragma unroll
      for (int db = 0; db < NDB; ++db)
#pragma unroll
        for (int pq = 0; pq < 2; ++pq) {
          float v[8];
          swap8(O[db], pq, v);
          st8(orow + 32 * db + 8 * (2 * pq + h), v, 1.f, nullptr);
        }
    } else {
      const float lt = l + xor32(l);
      const float inv = 1.f / lt;
      if (MODE != 3) {
#pragma unroll
        for (int db = 0; db < NDB; ++db)
#pragma unroll
          for (int pq = 0; pq < 2; ++pq) {
            float v[8];
            swap8(O[db], pq, v);
            st8(orow + 32 * db + 8 * (2 * pq + h), v, inv, nullptr);
          }
      } else if (pass == 0) {
#pragma unroll
        for (int db = 0; db < NDB; ++db)
#pragma unroll
          for (int g = 0; g < 4; ++g) {
            f32x4 v = {O[db][4 * g] * inv, O[db][4 * g + 1] * inv, O[db][4 * g + 2] * inv, O[db][4 * g + 3] * inv};
            *(f32x4*)(stash + tid * 64 + db * 16 + 4 * g) = v;
          }
      } else {
        const float li = lam * inv;
        float ss = 0.f;
#pragma unroll
        for (int db = 0; db < NDB; ++db)
#pragma unroll
          for (int g = 0; g < 4; ++g) {
            const f32x4 o1 = *(const f32x4*)(stash + tid * 64 + db * 16 + 4 * g);
#pragma unroll
            for (int e = 0; e < 4; ++e) { const float v = o1[e] - li * O[db][4 * g + e]; O[db][4 * g + e] = v; ss = fmaf(v, v, ss); }
          }
        ss += xor32(ss);
        const float rr = rsqrtf(ss * (1.f / 128.f) + EPS) * outscale;
#pragma unroll
        for (int db = 0; db < NDB; ++db)
#pragma unroll
          for (int pq = 0; pq < 2; ++pq) {
            const int d = 32 * db + 8 * (2 * pq + h);
            float v[8];
            swap8(O[db], pq, v);
            st8(orow + d, v, rr, subln + d);
          }
      }
    }
  }
}

DI int next_unit(int* ctr, unsigned char* lds) {
  volatile int* slot = (volatile int*)(lds + LDS_TILE_BYTES + 64);
  if (threadIdx.x == 0) *slot = atomicAdd(ctr, 1);
  __syncthreads();
  const int u = *slot;
  __syncthreads();
  return u;
}

DI void attn_even(const Params& p, int j, int*  , unsigned char* lds) {
  bf16_t* hb = (bf16_t*)(p.ws + WS_HID);
  bf16_t* mix = (bf16_t*)(p.ws + WS_MIX);
  int* qbase = (int*)(p.ws + WS_CTR) + 16 + j * 8;
  for (int xo = 0; xo < 8; ++xo) {
    const int hd = (blockIdx.x + xo) & 7;
    for (;;) {
      int v = next_unit(qbase + hd, lds);
      if (v >= 256) break;
      if (v < 128) {
        const int qi = 31 - (v & 31), b = v >> 5;
        const size_t sl = (size_t)(b * 8 + hd) * S;
        attn_unit<1>(hb + E_QB + sl * 96, hb + E_KB + sl * 96, hb + E_VB + sl * 64, nullptr, nullptr, qi, 0.f, 0.f, 0.f, 0.f, nullptr,
                     mix + ((size_t)b * S + qi * 256) * DM + 512 + hd * 64, nullptr, lds);
      } else {
        v -= 128;
        const int qi = 31 - (v >> 2), b = v & 3, g = hd >> 2;
        const size_t sl = (size_t)(b * 8 + hd) * S, slk = (size_t)(b * 2 + g) * S;
        const float slope2 = exp2f(-(float)(hd + 1)) * LOG2E;
        const float m0 = p.in[10][j * 8 + hd] * LOG2E;
        attn_unit<0>(hb + E_QA + sl * 64, hb + E_KA + slk * 64, hb + E_VA + slk * 64, nullptr, nullptr, qi, slope2, m0, 0.f, 0.f, nullptr,
                     mix + ((size_t)b * S + qi * 256) * DM + hd * 64, nullptr, lds);
      }
    }
  }
}

DI void attn_odd(const Params& p, int j, int* ctr, unsigned char* lds) {
  bf16_t* hb = (bf16_t*)(p.ws + WS_HID);
  bf16_t* mix = (bf16_t*)(p.ws + WS_MIX);
  const float* lf = p.in[21] + j * 256;
  float d01 = 0.f, d23 = 0.f;
  for (int i = 0; i < 64; ++i) { d01 = fmaf(lf[i], lf[64 + i], d01); d23 = fmaf(lf[128 + i], lf[192 + i], d23); }
  const float lambda_init = 0.8f - 0.6f * expf(-0.3f * (float)(2 * j + 1));
  const float lam = expf(d01) - expf(d23) + lambda_init;
  float bnd[2];
  for (int wh = 0; wh < 2; ++wh) {
    float gq = 0.f, gk = 0.f;
    for (int i = 0; i < 64; ++i) { gq = fmaxf(gq, fabsf(p.in[19][j * 128 + wh * 64 + i])); gk = fmaxf(gk, fabsf(p.in[20][j * 128 + wh * 64 + i])); }
    bnd[wh] = 8.f * LOG2E * 1.01f * gq * gk;
  }
  int* qbase = (int*)(p.ws + WS_CTR) + 32 + j * 8;
  for (int xo = 0; xo < 8; ++xo) {
    const int x = (blockIdx.x + xo) & 7;
    for (;;) {
      int v = next_unit(qbase + x, lds);
      if (v >= 192) break;
      if (v < 64) {
        const int qi = 31 - (v >> 1), b = x >> 1;
        const int hd = (v & 1) ? ((x & 1) ? 0 : 1) : ((x & 1) ? 3 : 2);
        const size_t sl0 = (size_t)((b * 4 + hd) * 2) * S, slv = (size_t)(b * 4 + hd) * S;
        const float slope2 = exp2f(-2.f * (float)(hd + 1)) * LOG2E;
        attn_unit<3>(hb + O_QD + sl0 * 64, hb + O_KD + sl0 * 64, hb + O_VD + slv * 128, hb + O_QD + (sl0 + S) * 64, hb + O_KD + (sl0 + S) * 64, qi, slope2,
                     0.f, lam, 1.f - lambda_init, p.in[22] + j * 128, mix + ((size_t)b * S + qi * 256) * DM + 512 + hd * 128,
                     (float*)(p.ws + WS_STASH) + (size_t)blockIdx.x * 32768, lds, bnd[0], bnd[1]);
      } else {
        v -= 64;
        const int qi = 31 - (v >> 2), b = v & 3, hd = x;
        const size_t sl = (size_t)(b * 8 + hd) * S;
        attn_unit<2>(hb + O_QC + sl * 64, hb + O_KC + sl * 64, hb + O_VC + sl * 64, nullptr, nullptr, qi, 0.f, 0.f, 0.f, 0.f, nullptr,
                     mix + ((size_t)b * S + qi * 256) * DM + hd * 64, nullptr, lds);
      }
    }
  }
}

#define XB_TMO      128
#define XB_XCNT(j)  (256  + 64 * (j))
#define XB_XSUB(j)  (1280 + 64 * (j))
#define XB_XGEN(j)  (2304 + 64 * (j))
#define XB_TOP      3328
#define XB_TOPGEN   3392
#define XCD_BAR_WORDS 3456
#define XB_SPIN_CAP (1u << 22)
DI unsigned xb_ld(unsigned* p) { return __hip_atomic_load(p, __ATOMIC_RELAXED, __HIP_MEMORY_SCOPE_AGENT); }
DI unsigned xb_add(unsigned* p, unsigned v) { return __hip_atomic_fetch_add(p, v, __ATOMIC_RELAXED, __HIP_MEMORY_SCOPE_AGENT); }
DI unsigned xb_xcc_id() { return (unsigned)__builtin_amdgcn_s_getreg((3 << 11) | 20) & 0xFu; }
#define XB_SPIN(cond, bar) do { unsigned _sp = 0; while (cond) { __builtin_amdgcn_s_sleep(1); \
    if ((++_sp & 255u) == 0u) { if (xb_ld(&(bar)[XB_TMO])) break; if (_sp > XB_SPIN_CAP) { atomicAdd(&(bar)[XB_TMO], 1u); break; } } } } while (0)
struct XcdBarrier { unsigned* bar; unsigned x; volatile LDS_AS unsigned* st; };
DI XcdBarrier xcd_barrier_post(unsigned* bar, volatile LDS_AS unsigned* st) {
  XcdBarrier b; b.bar = bar; b.x = xb_xcc_id(); b.st = st;
  if (threadIdx.x == 0) (void)xb_add(&bar[XB_XCNT(b.x)], 1u);
  return b;
}
DI void xcd_barrier_complete(unsigned* bar, unsigned x, unsigned& nloc, unsigned& nx) {
  const unsigned G = gridDim.x * gridDim.y * gridDim.z;
  unsigned sum, cnt, mine, sp = 0u;
  for (;;) {
    sum = 0u; cnt = 0u; mine = 0u;
#pragma unroll
    for (unsigned j = 0; j < 16; ++j) { const unsigned c = xb_ld(&bar[XB_XCNT(j)]); sum += c; cnt += (c > 0u) ? 1u : 0u; mine = (j == x) ? c : mine; }
    if (sum == G) break;
    __builtin_amdgcn_s_sleep(1);
    if ((++sp & 255u) == 0u) { if (xb_ld(&bar[XB_TMO])) break; if (sp > XB_SPIN_CAP) { atomicAdd(&bar[XB_TMO], 1u); break; } }
  }
  nloc = mine > 0u ? mine : 1u; nx = cnt > 0u ? cnt : 1u;
}
DI void xcd_barrier(const XcdBarrier& b) {
  asm volatile("s_waitcnt vmcnt(0)" ::: "memory");
  __syncthreads();
  if (threadIdx.x == 0) {
    unsigned* bar = b.bar;
    __builtin_amdgcn_s_waitcnt(0);
    unsigned nloc = b.st[0], nx = b.st[1];
    if (nloc == 0u) { xcd_barrier_complete(bar, b.x, nloc, nx); b.st[0] = nloc; b.st[1] = nx; }
    const unsigned old = xb_add(&bar[XB_XSUB(b.x)], 1u);
    const unsigned gen = old / nloc;
    if (old + 1u == (gen + 1u) * nloc) {
      __builtin_amdgcn_fence(__ATOMIC_RELEASE, "agent");
      asm volatile("s_waitcnt vmcnt(0)" ::: "memory");
      const unsigned og = xb_add(&bar[XB_TOP], 1u);
      const unsigned tg = og / nx;
      if (og + 1u == (tg + 1u) * nx) xb_add(&bar[XB_TOPGEN], 1u);
      else XB_SPIN(xb_ld(&bar[XB_TOPGEN]) == tg, bar);
      __builtin_amdgcn_fence(__ATOMIC_ACQUIRE, "agent");
      xb_add(&bar[XB_XGEN(b.x)], 1u);
      asm volatile("s_waitcnt vmcnt(0)" ::: "memory");
    } else {
      XB_SPIN(xb_ld(&bar[XB_XGEN(b.x)]) == gen, bar);
      __builtin_amdgcn_fence(__ATOMIC_ACQUIRE, "agent");
      asm volatile("s_waitcnt vmcnt(0)" ::: "memory");
    }
  }
  __syncthreads();
}

enum { K_PRO = 0, K_IN_E, K_UP_E, K_ATT_E, K_IN_O, K_ATT_O, K_OUT, K_MLPUP, K_DOWN };

extern "C" __global__ void __launch_bounds__(512) fwd_kernel(Params p, int ph_lo, int ph_hi) {
  extern __shared__ __attribute__((aligned(16))) unsigned char lds[];
  cg::grid_group grid = cg::this_grid();
  volatile LDS_AS unsigned* xst = (volatile LDS_AS unsigned*)(lds + LDS_TILE_BYTES + 96);
  if (threadIdx.x == 0) { xst[0] = 0u; xst[1] = 0u; }
  __syncthreads();
  XcdBarrier gbar = xcd_barrier_post((unsigned*)(p.ws + WS_BAR), xst);
  unsigned char* wb = p.ws + WS_W;
  bf16_t* xb = (bf16_t*)(p.ws + WS_XB);
  bf16_t* mix = (bf16_t*)(p.ws + WS_MIX);
  bf16_t* hb = (bf16_t*)(p.ws + WS_HID);
  int* ctr = (int*)(p.ws + WS_CTR);
  const int* pos = (const int*)p.in[1];
  for (int ph = ph_lo; ph < ph_hi; ++ph) {
    int kind = K_PRO, L = 0;
    if (ph > 0) {
      const int q = ph - 1, pair = q / 11, rr = q - pair * 11;
      if (rr < 6) { L = 2 * pair; kind = rr == 0 ? K_IN_E : rr == 1 ? K_UP_E : rr == 2 ? K_ATT_E : rr == 3 ? K_OUT : rr == 4 ? K_MLPUP : K_DOWN; }
      else { L = 2 * pair + 1; kind = rr == 6 ? K_IN_O : rr == 7 ? K_ATT_O : rr == 8 ? K_OUT : rr == 9 ? K_MLPUP : K_DOWN; }
    }
    const int j = L >> 1;
    for (int rep = 0; rep < ((kind == PROBE_KIND) ? 2 : 1); ++rep) {
    if (kind == K_PRO) {
      prologue(p, lds);
    } else if (kind == K_IN_E) {
      EpiEvenIn e{hb, p.in[8] + j * 64, p.in[9] + j * 64, p.in[12] + j * 128, lds};
      gemm_phase<true>(xb, 1024, (const bf16_t*)(wb + W_IN_E) + (size_t)j * 1280 * 1024, 1024, 5, e, lds);
    } else if (kind == K_UP_E) {
      EpiUQ e1{hb + E_QB, p.in[15] + j * 96, pos};
      gemm_phase<true>(hb + E_CQ, 256, (const bf16_t*)(wb + W_UQ) + (size_t)j * 1024 * 256, 256, 4, e1, lds);
      EpiUKV e2{hb + E_KB, hb + E_VB, (const float*)(hb + E_KR), p.in[16] + j * 96, pos};
      gemm_phase<false>(hb + E_CKV, 128, (const bf16_t*)(wb + W_UKV) + (size_t)j * 1024 * 128, 128, 4, e2, lds);
    } else if (kind == K_ATT_E) {
      attn_even(p, j, ctr + L + 4 * rep, lds);
    } else if (kind == K_IN_O) {
      EpiOddIn e{hb, p.in[19] + j * 128, p.in[20] + j * 128, lds};
      gemm_phase<true>(xb, 1024, (const bf16_t*)(wb + W_IN_O) + (size_t)j * 3072 * 1024, 1024, 12, e, lds);
    } else if (kind == K_ATT_O) {
      attn_odd(p, j, ctr + L + 4 * rep, lds);
    } else if (kind == K_OUT || kind == K_DOWN) {
      const bool isout = kind == K_OUT;
      EpiResid e{(isout && L == 0) ? p.in[0] : nullptr, xb, (!isout && L == 3) ? p.out : nullptr, lds};
      const bf16_t* Bt = isout ? ((L & 1) ? (const bf16_t*)(wb + W_OUT_O) : (const bf16_t*)(wb + W_OUT_E)) + (size_t)j * 1024 * 1024
                               : (const bf16_t*)(wb + W_DN) + (size_t)L * 1024 * 4096;
      gemm_phase<false>(isout ? mix : hb, isout ? 1024 : 4096, Bt, isout ? 1024 : 4096, 4, e, lds);
    } else {
      EpiRelu2 e{hb, lds};
      gemm_phase<true>(xb, 1024, (const bf16_t*)(wb + W_UP) + (size_t)L * 4096 * 1024, 1024, 16, e, lds);
    }
    if (PROBE_KIND >= 0) __syncthreads();
    }
    if (ph + 1 < ph_hi) {
      if (ph == ph_lo) grid.sync();
      else xcd_barrier(gbar);
    }
  }
}

extern "C" void kernel_launch(void* const* d_in, const int* in_sizes, int n_in, void* d_out, int out_size, void* d_ws, size_t ws_size,
                              hipStream_t stream) {
  static int grid_blocks = 0;
  if (grid_blocks == 0) {
    if (n_in != 23 || out_size != T * DM || ws_size < WS_END) {
      fprintf(stderr, "kernel_launch: unexpected shapes (n_in %d out %d ws %zu need %zu)\n", n_in, out_size, ws_size, (size_t)WS_END);
      grid_blocks = -1;
      return;
    }
    int dev = 0, cus = 0, per_cu = 0;
    hipGetDevice(&dev);
    hipDeviceGetAttribute(&cus, hipDeviceAttributeMultiprocessorCount, dev);
    if (hipFuncSetAttribute((const void*)fwd_kernel, hipFuncAttributeMaxDynamicSharedMemorySize, LDS_BYTES) != hipSuccess)
      fprintf(stderr, "kernel_launch: hipFuncSetAttribute failed\n");
    hipOccupancyMaxActiveBlocksPerMultiprocessor(&per_cu, (const void*)fwd_kernel, NT, LDS_BYTES);
    if (per_cu > 1) per_cu = 1;
    if (per_cu < 1) { fprintf(stderr, "kernel_launch: occupancy query gave %d\n", per_cu); per_cu = 1; }
    grid_blocks = cus * per_cu;
  }
  if (grid_blocks < 0) return;
  Params p{};
  for (int i = 0; i < 23; ++i) p.in[i] = (const float*)d_in[i];
  p.out = (float*)d_out;
  p.ws = (unsigned char*)d_ws;
  if (hipMemsetAsync((char*)d_ws + WS_BAR, 0, 16384, stream) != hipSuccess) fprintf(stderr, "kernel_launch: memset of barrier words failed\n");
#if MULTI_LAUNCH
  for (int ph = 0; ph < NPHASE; ++ph) hipLaunchKernelGGL(fwd_kernel, dim3(grid_blocks), dim3(NT), LDS_BYTES, stream, p, ph, ph + 1);
#else
  int lo = 0, hi = NPHASE;
  void* args[] = {&p, &lo, &hi};
  hipError_t e = hipLaunchCooperativeKernel((const void*)fwd_kernel, dim3(grid_blocks), dim3(NT), args, LDS_BYTES, stream);
  if (e != hipSuccess) fprintf(stderr, "cooperative launch failed: %s (grid %d)\n", hipGetErrorString(e), grid_blocks);
#endif
}
```
